# Optimizing an MI355X kernel written in HIP

```python
import math
import jax, jax.numpy as jnp
from jax import lax
import numpy as np

D_MODEL = 2048
BATCH = 2
SEQ = 16384
DEPTH = 1

CHUNK = 64
D_MIX = D_MODEL
D_CONV = D_MIX // 2
D_MLSTM = D_MIX - D_CONV
CONV_K = 3
M_HEADS = 8
M_HEAD_DIM = D_MLSTM // M_HEADS
D_IN = 3 * D_CONV + 4 * D_MLSTM + 2 * M_HEADS
PEER_HEADS = 8
N_KEYS = 128
N_EXPERTS = N_KEYS * N_KEYS
PEER_TOPK = 16
PEER_QDIM = 256
PEER_HALF = PEER_QDIM // 2
PEER_BLOCK = 128
ALPHA = (2 * DEPTH) ** 0.25
BETA = (8 * DEPTH) ** -0.25
LN_EPS = 1e-5

kernel_name = "hybrid_conv_mlstm_peer_deepnorm"


def layernorm(x, g, b):
    xf = x.astype(jnp.float32)
    mu = jnp.mean(xf, axis=-1, keepdims=True)
    xc = xf - mu
    var = jnp.mean(xc * xc, axis=-1, keepdims=True)
    y = xc * lax.rsqrt(var + LN_EPS) * g.astype(jnp.float32) + b.astype(jnp.float32)
    return y.astype(x.dtype)


def causal_dwconv(z, w, b):
    S = z.shape[1]
    zp = jnp.pad(z, ((0, 0), (CONV_K - 1, 0), (0, 0)))
    y = b
    for j in range(CONV_K):
        y = y + w[j] * zp[:, j:j + S]
    return y


def mlstm_chunkwise(q, k, v, logi, logf):
    Bn, S, H, dh = q.shape
    L = CHUNK
    NC = S // L
    f32 = jnp.float32
    def to_chunks(t):
        return t.astype(f32).reshape(Bn, NC, L, H, dh).transpose(1, 0, 3, 2, 4)
    qc = to_chunks(q)
    kc = to_chunks(k) * (dh ** -0.5)
    vc = to_chunks(v)
    li = logi.astype(f32).reshape(Bn, NC, L, H).transpose(1, 0, 3, 2)
    lf = logf.astype(f32).reshape(Bn, NC, L, H).transpose(1, 0, 3, 2)
    mask = jnp.tril(jnp.ones((L, L), dtype=bool))

    def step(carry, inp):
        C, n, m = carry
        qb, kb, vb, lib, lfb = inp
        bcum = jnp.cumsum(lfb, axis=-1)
        Dm = bcum[..., :, None] - bcum[..., None, :] + lib[..., None, :]
        Dm = jnp.where(mask, Dm, -jnp.inf)
        inter = bcum + m[..., None]
        m_t = jnp.maximum(inter, jnp.max(Dm, axis=-1))
        w_intra = jnp.exp(Dm - m_t[..., None])
        w_inter = jnp.exp(inter - m_t)
        s = jnp.einsum('bhld,bhjd->bhlj', qb, kb) * w_intra
        num = (jnp.einsum('bhlj,bhjd->bhld', s, vb)
               + w_inter[..., None] * jnp.einsum('bhed,bhld->bhle', C, qb))
        den = jnp.sum(s, axis=-1) + w_inter * jnp.einsum('bhd,bhld->bhl', n, qb)
        h = num / jnp.maximum(jnp.abs(den), jnp.exp(-m_t))[..., None]
        bL = bcum[..., -1]
        g = bL[..., None] - bcum + lib
        m_new = jnp.maximum(bL + m, jnp.max(g, axis=-1))
        wk = jnp.exp(g - m_new[..., None])
        decay = jnp.exp(bL + m - m_new)
        C_new = decay[..., None, None] * C + jnp.einsum('bhl,bhle,bhld->bhed', wk, vb, kb)
        n_new = decay[..., None] * n + jnp.einsum('bhl,bhld->bhd', wk, kb)
        return (C_new, n_new, m_new), h

    init = (jnp.zeros((Bn, H, dh, dh), f32), jnp.zeros((Bn, H, dh), f32),
            jnp.zeros((Bn, H), f32))
    _, hs = lax.scan(step, init, (qc, kc, vc, li, lf))
    return hs.transpose(1, 0, 3, 2, 4).reshape(Bn, S, H, dh).astype(q.dtype)


def peer_ffn(h, wq, keys, u, v):
    Bn, S, D = h.shape
    xb = h.reshape(-1, PEER_BLOCK, D)

    def block(xt):
        q = (xt @ wq).reshape(-1, PEER_HEADS, 2, PEER_HALF)
        s = jnp.einsum('thpc,hpnc->thpn', q, keys)
        sv, si = lax.top_k(s, PEER_TOPK)
        cand = (sv[:, :, 0, :, None] + sv[:, :, 1, None, :]).reshape(-1, PEER_HEADS, PEER_TOPK * PEER_TOPK)
        cid = (si[:, :, 0, :, None] * N_KEYS + si[:, :, 1, None, :]).reshape(-1, PEER_HEADS, PEER_TOPK * PEER_TOPK)
        top_s, top_j = lax.top_k(cand, PEER_TOPK)
        eid = jnp.take_along_axis(cid, top_j, axis=-1)
        gate = jax.nn.softmax(top_s.astype(jnp.float32), axis=-1)
        ue = jnp.take(u, eid, axis=0)
        act = jax.nn.gelu(jnp.einsum('thkd,td->thk', ue, xt).astype(jnp.float32), approximate=False)
        ve = jnp.take(v, eid, axis=0)
        return jnp.einsum('thk,thkd->td', (gate * act).astype(xt.dtype), ve)

    return lax.map(block, xb).reshape(Bn, S, D)


def setup_inputs(seed: int = 0) -> dict:
    key = jax.random.key(seed)
    ks = jax.random.split(key, 20)
    f32 = jnp.float32
    nrm = lambda k, shape: jax.random.normal(k, shape, f32)
    x = nrm(ks[0], (BATCH, SEQ, D_MODEL))
    ln_in_g = 1.0 + 0.05 * nrm(ks[1], (D_MODEL,))
    ln_in_b = 0.01 * nrm(ks[2], (D_MODEL,))
    col_scale = jnp.concatenate([
        jnp.ones((2 * D_CONV,), f32), jnp.full((D_CONV,), BETA, f32),
        jnp.ones((2 * D_MLSTM,), f32), jnp.full((D_MLSTM,), BETA, f32),
        jnp.ones((D_MLSTM + 2 * M_HEADS,), f32)])
    w_in = nrm(ks[3], (DEPTH, D_MODEL, D_IN)) * (D_MODEL ** -0.5) * col_scale
    b_i = 0.1 * nrm(ks[4], (DEPTH, M_HEADS))
    b_f = jnp.linspace(3.0, 6.0, M_HEADS, dtype=f32) + 0.1 * nrm(ks[5], (DEPTH, M_HEADS))
    b_gate = jnp.concatenate([b_i, b_f], axis=-1)
    conv_w = nrm(ks[6], (DEPTH, CONV_K, D_CONV)) * (CONV_K ** -0.5)
    conv_b = 0.01 * nrm(ks[7], (DEPTH, D_CONV))
    mh_norm_g = 1.0 + 0.05 * nrm(ks[8], (DEPTH, D_MLSTM))
    w_out = nrm(ks[9], (DEPTH, D_MIX, D_MODEL)) * (D_MIX ** -0.5) * BETA
    ln1_g = 1.0 + 0.05 * nrm(ks[10], (DEPTH, D_MODEL))
    ln1_b = 0.01 * nrm(ks[11], (DEPTH, D_MODEL))
    peer_wq = nrm(ks[12], (DEPTH, D_MODEL, PEER_HEADS * PEER_QDIM)) * (D_MODEL ** -0.5)
    peer_keys = nrm(ks[13], (DEPTH, PEER_HEADS, 2, N_KEYS, PEER_HALF)) * (PEER_HALF ** -0.5)
    peer_u = nrm(ks[14], (DEPTH, N_EXPERTS, D_MODEL)) * (D_MODEL ** -0.5) * BETA
    peer_v = nrm(ks[15], (DEPTH, N_EXPERTS, D_MODEL)) * (PEER_HEADS ** -0.5) * BETA
    ln2_g = 1.0 + 0.05 * nrm(ks[16], (DEPTH, D_MODEL))
    ln2_b = 0.01 * nrm(ks[17], (DEPTH, D_MODEL))
    return {"x": x, "ln_in_g": ln_in_g, "ln_in_b": ln_in_b, "w_in": w_in, "b_gate": b_gate,
            "conv_w": conv_w, "conv_b": conv_b, "mh_norm_g": mh_norm_g, "w_out": w_out,
            "ln1_g": ln1_g, "ln1_b": ln1_b, "peer_wq": peer_wq, "peer_keys": peer_keys,
            "peer_u": peer_u, "peer_v": peer_v, "ln2_g": ln2_g, "ln2_b": ln2_b}


def reference(x, ln_in_g, ln_in_b, w_in, b_gate, conv_w, conv_b, mh_norm_g, w_out,
              ln1_g, ln1_b, peer_wq, peer_keys, peer_u, peer_v, ln2_g, ln2_b):
    Bn, S, D = x.shape
    split_at = np.cumsum([D_CONV, D_CONV, D_CONV, D_MLSTM, D_MLSTM, D_MLSTM, D_MLSTM, M_HEADS]).tolist()
    h = layernorm(x, ln_in_g, ln_in_b)
    for l in range(DEPTH):
        proj = h @ w_in[l]
        cB, cC, ch, q, k, v, o, gi, gf = jnp.split(proj, split_at, axis=-1)
        y_conv = cB * causal_dwconv(cC * ch, conv_w[l], conv_b[l])
        gates = (jnp.concatenate([gi, gf], axis=-1) + b_gate[l]).astype(jnp.float32)
        logi = gates[..., :M_HEADS]
        logf = jax.nn.log_sigmoid(gates[..., M_HEADS:])
        hd = lambda t: t.reshape(Bn, S, M_HEADS, M_HEAD_DIM)
        hm = mlstm_chunkwise(hd(q), hd(k), hd(v), logi, logf)
        hm = layernorm(hm, mh_norm_g[l].reshape(M_HEADS, M_HEAD_DIM),
                       jnp.zeros((M_HEADS, M_HEAD_DIM), hm.dtype))
        y_m = jax.nn.sigmoid(o) * hm.reshape(Bn, S, D_MLSTM)
        mix = jnp.concatenate([y_conv, y_m], axis=-1) @ w_out[l]
        h = layernorm(ALPHA * h + mix, ln1_g[l], ln1_b[l])
        ff = peer_ffn(h, peer_wq[l], peer_keys[l], peer_u[l], peer_v[l])
        h = layernorm(ALPHA * h + ff, ln2_g[l], ln2_b[l])
    return h
```

```cpp
#include <hip/hip_runtime.h>
#include <hip/hip_cooperative_groups.h>
#include <cstdio>
namespace cg = cooperative_groups;

typedef unsigned short u16;
typedef float f32x16 __attribute__((ext_vector_type(16)));

#define T_TOK 32768
#define SEQ_L 16384
#define DM 2048
#define DIN 7184
#define NPJ 7168
#define ALPHA_F 1.189207115002721f
#define LN_EPS_F 1e-5f
#define QK_SCALE 0.08838834764831845f

#define MIB ((size_t)1 << 20)
#define OFF_H0B   (0 * MIB)
#define OFF_PROJ  (128 * MIB)
#define OFF_YMIX  (576 * MIB)
#define OFF_H1B   (704 * MIB)
#define OFF_WINT  (832 * MIB)
#define OFF_WOUTT (860 * MIB)
#define OFF_WQT   (868 * MIB)
#define OFF_KEYB  (876 * MIB)
#define OFF_UBF   (877 * MIB)
#define OFF_VBF   (941 * MIB)
#define OFF_GATES (1005 * MIB)
#define OFF_DN    (1007 * MIB)
#define OFF_MG    (1009 * MIB)
#define OFF_BL    (1009 * MIB + 65536)
#define OFF_MST   (1009 * MIB + 131072)
#define OFF_QB    (128 * MIB)
#define OFF_EID   (256 * MIB)
#define OFF_GW    (272 * MIB)

struct Params {
    const float *x, *ln_in_g, *ln_in_b, *w_in, *b_gate, *conv_w, *conv_b, *mh_g, *w_out, *ln1_g, *ln1_b, *wq, *keys, *pu, *pv, *ln2_g, *ln2_b;
    float* out; unsigned char* ws;
};

__device__ __forceinline__ unsigned pk2(float lo, float hi) { unsigned r; asm("v_cvt_pk_bf16_f32 %0, %1, %2" : "=v"(r) : "v"(lo), "v"(hi)); return r; }
__device__ __forceinline__ float bflo(unsigned w) { return __uint_as_float(w << 16); }
__device__ __forceinline__ float bfhi(unsigned w) { return __uint_as_float(w & 0xffff0000u); }
__device__ __forceinline__ float bf1(u16 b) { return __uint_as_float(((unsigned)b) << 16); }
__device__ __forceinline__ void unpack8(const uint4 w, float (&f)[8]) {
    f[0] = bflo(w.x); f[1] = bfhi(w.x); f[2] = bflo(w.y); f[3] = bfhi(w.y); f[4] = bflo(w.z); f[5] = bfhi(w.z); f[6] = bflo(w.w); f[7] = bfhi(w.w);
}
__device__ __forceinline__ float wsum(float v) {
#pragma unroll
    for (int o = 32; o; o >>= 1) v += __shfl_xor(v, o);
    return v;
}
__device__ __forceinline__ float wmaxf(float v) {
#pragma unroll
    for (int o = 32; o; o >>= 1) v = fmaxf(v, __shfl_xor(v, o));
    return v;
}
__device__ __forceinline__ float wscan_add(float v, int lane) {
#pragma unroll
    for (int o = 1; o < 64; o <<= 1) { const float t = __shfl_up(v, o); if (lane >= o) v += t; }
    return v;
}
__device__ __forceinline__ float wscan_max(float v, int lane) {
#pragma unroll
    for (int o = 1; o < 64; o <<= 1) { const float t = __shfl_up(v, o); if (lane >= o) v = fmaxf(v, t); }
    return v;
}
namespace pg8 {
#define PG8_LAS __attribute__((address_space(3)))
typedef unsigned short bf16_t;
typedef short bf16x8 __attribute__((ext_vector_type(8)));
typedef float f32x4 __attribute__((ext_vector_type(4)));
typedef unsigned u32x4 __attribute__((ext_vector_type(4)));
constexpr int BM = 256, BK = 64, HALF = 128, HTB = HALF * BK * 2  , STAGE_BYTES = 8 * HTB, NXCD = 8, WGM = 8;

__host__ __device__ __forceinline__ int lds_byte(int r, int c) { const int st = (r >> 4) * 2 + (c >> 5), rr = r & 15, cc = c & 31, ob = rr * 64 + cc * 2; return st * 1024 + (ob ^ (((ob >> 9) & 1) << 5)); }
__host__ __device__ __forceinline__ void stage_rc(int b, int& R, int& C) { const int st = b / 1024, sb = b % 1024, swz = sb ^ (((sb >> 9) & 1) << 5); R = (st >> 1) * 16 + swz / 64; C = (st & 1) * 32 + (swz % 64) / 2; }
__host__ __device__ __forceinline__ int perm32(int rho) { const int n = rho >> 4, i = rho & 15; return 8 * (i >> 2) + 4 * n + (i & 3); }

struct Unit { int pm, pn; };
struct Gemm { const bf16_t* A; const bf16_t* Bt; int M, N, K; };

struct StaticOrder {
    int nM, nN, nwg, G, c;
    __host__ __device__ void init(int M, int N, int G_, int c_) { nM = M / BM; nN = N / BM; nwg = nM * nN; G = G_; c = c_; }
    __host__ __device__ bool next(int i, Unit& u) const {
        const long L = (long)i * G + c; if (L >= nwg) return false;
        int wgid = (int)L; { const int q = nwg / NXCD, r = nwg % NXCD, xcd = wgid % NXCD, off = wgid / NXCD; wgid = (xcd < r ? xcd * (q + 1) : r * (q + 1) + (xcd - r) * q) + off; }
        const int nig = WGM * nN, gid = wgid / nig, fm = gid * WGM, gsz = (nM - fm) < WGM ? (nM - fm) : WGM;
        u.pm = fm + ((wgid % nig) % gsz); u.pn = (wgid % nig) / gsz; return true;
    }
    __device__ __forceinline__ void a_ready(const Unit&) const {}
    __device__ __forceinline__ void done(const Unit&) const {}
};
struct CountedOrder : StaticOrder {
    const unsigned* ready; unsigned need; unsigned* tmo;
    __device__ __forceinline__ void a_ready(const Unit& u) const {
        if (threadIdx.x < 64) {
            const unsigned long long t0 = __builtin_amdgcn_s_memrealtime(); unsigned polls = 0;
            while ((unsigned)__builtin_amdgcn_readfirstlane(__hip_atomic_load(ready + 64 * u.pm, __ATOMIC_RELAXED, __HIP_MEMORY_SCOPE_AGENT)) < need) {
                if ((++polls & 255u) == 0u && __builtin_amdgcn_readfirstlane(__hip_atomic_load(tmo, __ATOMIC_RELAXED, __HIP_MEMORY_SCOPE_AGENT)) != 0u) break;
                if (__builtin_amdgcn_s_memrealtime() - t0 > 2000000ull) {
                    if (threadIdx.x == 0) { unsigned expect = 0u; __hip_atomic_compare_exchange_strong(tmo + 1, &expect, 0x600u | (unsigned)(u.pm & 0xff), __ATOMIC_RELAXED, __ATOMIC_RELAXED, __HIP_MEMORY_SCOPE_AGENT); __hip_atomic_store(tmo, 1u, __ATOMIC_RELAXED, __HIP_MEMORY_SCOPE_AGENT); }
                    break; }
                __builtin_amdgcn_s_sleep(2); }
            __builtin_amdgcn_fence(__ATOMIC_ACQUIRE, "agent");
            asm volatile("s_waitcnt vmcnt(0)" ::: "memory");
        }
#if !defined(BROKEN_HOOK_NO_BARRIER)
        asm volatile("" ::: "memory"); __builtin_amdgcn_s_barrier(); asm volatile("" ::: "memory");
#endif
    }
};

__device__ __forceinline__ unsigned cvt_pk_bf16(float lo, float hi) { unsigned r; asm volatile("v_cvt_pk_bf16_f32 %0, %1, %2" : "=v"(r) : "v"(lo), "v"(hi)); return r; }
typedef float f32x2 __attribute__((ext_vector_type(2)));
__device__ __forceinline__ f32x2 gelu_pk(f32x2 v) {
    const f32x2 av = __builtin_elementwise_abs(v), d = av * 0.2316418882f + 1.0f;
    f32x2 t; t.x = __builtin_amdgcn_rcpf(d.x); t.y = __builtin_amdgcn_rcpf(d.y);
    f32x2 q = t * 0.5307027145f + (-0.7265760135f); q = q * t + 0.7107068705f; q = q * t + (-0.142248368f); q = q * t + 0.127414796f; q = q * t;
    const f32x2 s = (v * v) * (-0.72134752044f);
    f32x2 e; e.x = __builtin_amdgcn_exp2f(s.x); e.y = __builtin_amdgcn_exp2f(s.y);
    const f32x2 m = v * (q * e), r = v - m;
    f32x2 o; o.x = v.x < 0.f ? m.x : r.x; o.y = v.y < 0.f ? m.y : r.y; return o;
}

struct EpiF32 {
    static constexpr bool PERM = false, AFTER_DRAIN = false;
    float* C; int ldc; const float* bias;
    __device__ __forceinline__ void operator()(const f32x4 (&acc)[2][2][4][2], const Unit& u, int wr, int wc, int fr, int fq) const {
        const int row0 = u.pm * BM + wr * 64 + fr, col0 = u.pn * BM + wc * 32 + 4 * fq;
        f32x4 bv[2][2];
#pragma unroll
        for (int bj = 0; bj < 2; ++bj)
#pragma unroll
            for (int n = 0; n < 2; ++n) bv[bj][n] = bias ? *(const f32x4*)(bias + col0 + bj * HALF + n * 16) : (f32x4){0.f, 0.f, 0.f, 0.f};
#pragma unroll
        for (int ai = 0; ai < 2; ++ai)
#pragma unroll
            for (int m = 0; m < 4; ++m) { float* rowp = C + (size_t)(row0 + ai * HALF + m * 16) * ldc + col0;
#pragma unroll
                for (int bj = 0; bj < 2; ++bj)
#pragma unroll
                    for (int n = 0; n < 2; ++n) *(f32x4*)(rowp + bj * HALF + n * 16) = acc[ai][bj][m][n] + bv[bj][n]; }
    }
};
template <int ACT  > struct EpiBf16 {
    static constexpr bool PERM = true, AFTER_DRAIN = false;
    bf16_t* O; int ldc; const float* bias; int split_cols; size_t split_stride;
    __device__ __forceinline__ void operator()(const f32x4 (&acc)[2][2][4][2], const Unit& u, int wr, int wc, int fr, int fq) const {
        const int row0 = u.pm * BM + wr * 64 + fr; int colt = u.pn * BM; bf16_t* base = O;
        if (split_cols) { const int t = colt / split_cols; base += (size_t)t * split_stride; colt -= t * split_cols; }
        const int col0 = colt + wc * 32 + 8 * fq, bcol0 = u.pn * BM + wc * 32 + 8 * fq;
        f32x4 bv[2][2];
#pragma unroll
        for (int bj = 0; bj < 2; ++bj)
#pragma unroll
            for (int n = 0; n < 2; ++n) bv[bj][n] = bias ? *(const f32x4*)(bias + bcol0 + bj * HALF + 4 * n) : (f32x4){0.f, 0.f, 0.f, 0.f};
#pragma unroll
        for (int ai = 0; ai < 2; ++ai)
#pragma unroll
            for (int m = 0; m < 4; ++m) { bf16_t* rowp = base + (size_t)(row0 + ai * HALF + m * 16) * ldc + col0;
#pragma unroll
                for (int bj = 0; bj < 2; ++bj) { f32x4 v0 = acc[ai][bj][m][0] + bv[bj][0], v1 = acc[ai][bj][m][1] + bv[bj][1];
                    if (ACT == 1) { f32x2 a = gelu_pk((f32x2){v0[0], v0[1]}), b = gelu_pk((f32x2){v0[2], v0[3]}), c = gelu_pk((f32x2){v1[0], v1[1]}), d = gelu_pk((f32x2){v1[2], v1[3]});
                        v0 = (f32x4){a.x, a.y, b.x, b.y}; v1 = (f32x4){c.x, c.y, d.x, d.y}; }
                    if (ACT == 2) {
#pragma unroll
                        for (int j = 0; j < 4; ++j) { v0[j] = 0.5f * v0[j] * (1.0f + erff(v0[j] * 0.70710678f)); v1[j] = 0.5f * v1[j] * (1.0f + erff(v1[j] * 0.70710678f)); } }
                    u32x4 w; w.x = cvt_pk_bf16(v0[0], v0[1]); w.y = cvt_pk_bf16(v0[2], v0[3]); w.z = cvt_pk_bf16(v1[0], v1[1]); w.w = cvt_pk_bf16(v1[2], v1[3]);
                    *(u32x4*)(rowp + bj * HALF) = w; } }
    }
};
template <class Epi, class Sched, bool STAMP = false>
__device__ __forceinline__ void gemm_phase(PG8_LAS unsigned char* lds, const Gemm g, const Sched& S, const Epi& E, unsigned long long* stamps) {
    const int tid = threadIdx.x, wid = __builtin_amdgcn_readfirstlane(tid >> 6), lane = tid & 63, wr = wid >> 2, wc = wid & 3, fr = lane & 15, fq = lane >> 4;
    const int K = g.K, nt = K / BK;
    int ts_lo = 0, ts_hi = 0, nts = 0; const unsigned long long rt_entry = STAMP ? (unsigned long long)wall_clock64() : 0ull;
#define PG8_STAMP() do { if (STAMP && wid == 0 && nts < 64) { const unsigned long long _c = (unsigned long long)clock64(); \
        ts_lo = (lane == nts) ? (int)(unsigned)_c : ts_lo; ts_hi = (lane == nts) ? (int)(unsigned)(_c >> 32) : ts_hi; ++nts; } } while (0)
    PG8_STAMP();
    unsigned voffA[2], voffB[2];
#pragma unroll
    for (int i = 0; i < 2; ++i) { int R, C; stage_rc(tid * 16 + i * 8192, R, C); const int Rb = Epi::PERM ? ((R & ~31) + perm32(R & 31)) : R;
        voffA[i] = (unsigned)(R * K + C) * 2u; voffB[i] = (unsigned)(Rb * K + C) * 2u; }
    const size_t kstep = (size_t)(BK * 2);
    const size_t hstep = (size_t)HALF * K * 2;
    const size_t tstep = 2 * hstep;
    const unsigned ldsw = (unsigned)wid * 1024u;
    const int aoff = lds_byte(wr * 64 + fr, fq * 8), boff = lds_byte(wc * 32 + fr, fq * 8);
#define PG8_SA(b, h) (((b) * 2 + (h)) * HTB)
#define PG8_SB(b, h) ((4 + (b) * 2 + (h)) * HTB)
#define PG8_STAGE(bufoff, gbase, voff) do { _Pragma("unroll") for (int _i = 0; _i < 2; ++_i) \
        __builtin_amdgcn_global_load_lds((const unsigned*)((const char*)(gbase) + (voff)[_i]), (PG8_LAS unsigned*)(lds + (bufoff) + ldsw + _i * 8192), 16, 0, 0); } while (0)
#define PG8_LDA(dst, b, h) do { _Pragma("unroll") for (int m = 0; m < 4; ++m) _Pragma("unroll") for (int k = 0; k < 2; ++k) dst[m][k] = *(const PG8_LAS bf16x8*)(lds + PG8_SA(b, h) + aoff + m * 2048 + k * 1024); } while (0)
#define PG8_LDB(dst, b, h) do { _Pragma("unroll") for (int n = 0; n < 2; ++n) _Pragma("unroll") for (int k = 0; k < 2; ++k) dst[n][k] = *(const PG8_LAS bf16x8*)(lds + PG8_SB(b, h) + boff + n * 2048 + k * 1024); } while (0)
#define PG8_MMA(ai, bj, At, Bt) do { __builtin_amdgcn_s_setprio(1); _Pragma("unroll") for (int m = 0; m < 4; ++m) _Pragma("unroll") for (int n = 0; n < 2; ++n) _Pragma("unroll") for (int k = 0; k < 2; ++k) \
        acc[ai][bj][m][n] = __builtin_amdgcn_mfma_f32_16x16x32_bf16(Bt[n][k], At[m][k], acc[ai][bj][m][n], 0, 0, 0); __builtin_amdgcn_s_setprio(0); } while (0)
#define PG8_WAIT_V(n) asm volatile("s_waitcnt vmcnt(" #n ")" ::: "memory")
#define PG8_WAIT_L(n) asm volatile("s_waitcnt lgkmcnt(" #n ")" ::: "memory")
#define PG8_BAR __builtin_amdgcn_s_barrier()
#define PG8_SCHED __builtin_amdgcn_sched_barrier(0)
    Unit cur, nxt; int ui = 0;
    if (!S.next(0, cur)) return;
    f32x4 acc[2][2][4][2];
#pragma unroll
    for (int a = 0; a < 2; ++a)
#pragma unroll
        for (int b = 0; b < 2; ++b)
#pragma unroll
            for (int m = 0; m < 4; ++m)
#pragma unroll
                for (int n = 0; n < 2; ++n) acc[a][b][m][n] = (f32x4){0.f, 0.f, 0.f, 0.f};
    bf16x8 At[4][2], B0[2][2], B1[2][2];
    const char* cA = (const char*)g.A + (size_t)cur.pm * tstep; const char* cB = (const char*)g.Bt + (size_t)cur.pn * tstep;
    S.a_ready(cur);
    PG8_STAGE(PG8_SB(0, 0), cB, voffB); PG8_STAGE(PG8_SA(0, 0), cA, voffA); PG8_STAGE(PG8_SB(0, 1), cB + hstep, voffB); PG8_STAGE(PG8_SA(0, 1), cA + hstep, voffA);
    if (wr == 1) PG8_BAR;
    PG8_WAIT_V(4); PG8_BAR;
    PG8_STAGE(PG8_SB(1, 0), cB + kstep, voffB); PG8_STAGE(PG8_SA(1, 0), cA + kstep, voffA); PG8_STAGE(PG8_SB(1, 1), cB + hstep + kstep, voffB);
    PG8_WAIT_V(6); PG8_BAR;
    PG8_STAMP();
    for (;;) {
        const bool has_next = S.next(ui + 1, nxt);
        const char* nA = has_next ? (const char*)g.A + (size_t)nxt.pm * tstep : cA; const char* nB = has_next ? (const char*)g.Bt + (size_t)nxt.pn * tstep : cB;
        for (int t = 0; t < nt; t += 2) {
            const bool last = (t == nt - 2);
            const char* a1 = cA + (size_t)(t + 1) * kstep;
            const char* a2 = last ? nA : cA + (size_t)(t + 2) * kstep; const char* b2 = last ? nB : cB + (size_t)(t + 2) * kstep;
            const char* a3 = a2 + kstep; const char* b3 = b2 + kstep;
            if (last && has_next) S.a_ready(nxt);
            PG8_LDB(B0, 0, 0); PG8_SCHED; PG8_LDA(At, 0, 0); PG8_STAGE(PG8_SA(1, 1), a1 + hstep, voffA);
            PG8_WAIT_L(8); PG8_BAR; PG8_WAIT_L(0); PG8_MMA(0, 0, At, B0); PG8_BAR; PG8_SCHED;
            PG8_LDB(B1, 0, 1); PG8_STAGE(PG8_SB(0, 0), b2, voffB);
            PG8_BAR; PG8_WAIT_L(0); PG8_MMA(0, 1, At, B1); PG8_BAR;
            PG8_LDA(At, 0, 1); PG8_STAGE(PG8_SA(0, 0), a2, voffA);
            PG8_BAR; PG8_WAIT_L(0); PG8_MMA(1, 0, At, B0); PG8_BAR; PG8_SCHED;
            PG8_STAGE(PG8_SB(0, 1), b2 + hstep, voffB);
            PG8_WAIT_V(6); PG8_BAR; PG8_MMA(1, 1, At, B1); PG8_BAR;
            PG8_LDB(B0, 1, 0); PG8_SCHED; PG8_LDA(At, 1, 0); PG8_STAGE(PG8_SA(0, 1), a2 + hstep, voffA);
            PG8_WAIT_L(8); PG8_BAR; PG8_WAIT_L(0); PG8_MMA(0, 0, At, B0); PG8_BAR; PG8_SCHED;
            PG8_LDB(B1, 1, 1); PG8_STAGE(PG8_SB(1, 0), b3, voffB);
            PG8_BAR; PG8_WAIT_L(0); PG8_MMA(0, 1, At, B1); PG8_BAR;
            PG8_LDA(At, 1, 1); PG8_STAGE(PG8_SA(1, 0), a3, voffA);
            PG8_BAR; PG8_WAIT_L(0); PG8_MMA(1, 0, At, B0); PG8_BAR; PG8_SCHED;
            PG8_STAGE(PG8_SB(1, 1), b3 + hstep, voffB);
            PG8_WAIT_V(6); PG8_BAR; PG8_MMA(1, 1, At, B1); PG8_BAR;
        }
        PG8_STAMP();
        if constexpr (!Epi::AFTER_DRAIN) { E(acc, cur, wr, wc, fr, fq); S.done(cur); }
        PG8_STAMP();
        if (!has_next) break;
#pragma unroll
        for (int a = 0; a < 2; ++a)
#pragma unroll
            for (int b = 0; b < 2; ++b)
#pragma unroll
                for (int m = 0; m < 4; ++m)
#pragma unroll
                    for (int n = 0; n < 2; ++n) acc[a][b][m][n] = (f32x4){0.f, 0.f, 0.f, 0.f};
        cur = nxt; cA = nA; cB = nB; ++ui;
    }
    PG8_WAIT_V(0);
    if (wr == 0) PG8_BAR;
    PG8_BAR;
    if constexpr (Epi::AFTER_DRAIN) { E.fused(acc, cur, wr, wc, fr, fq, lds, wid, lane); S.done(cur); }
    PG8_STAMP();
    if (STAMP && wid == 0) { stamps[lane] = lane < nts ? (((unsigned long long)(unsigned)ts_hi << 32) | (unsigned)ts_lo) : 0ull;
        if (lane == 62) stamps[62] = rt_entry; if (lane == 63) stamps[63] = (unsigned long long)wall_clock64(); }
#undef PG8_STAMP
#undef PG8_SA
#undef PG8_SB
#undef PG8_STAGE
#undef PG8_LDA
#undef PG8_LDB
#undef PG8_MMA
#undef PG8_WAIT_V
#undef PG8_WAIT_L
#undef PG8_BAR
#undef PG8_SCHED
}
}

using pg8::bf16x8; using pg8::f32x4;

__device__ void phase_prep(const Params& p, unsigned char* smem) {
    const int tid = threadIdx.x, lane = tid & 63, wave = tid >> 6;
    u16* winT = (u16*)(p.ws + OFF_WINT); u16* woutT = (u16*)(p.ws + OFF_WOUTT); u16* wqT = (u16*)(p.ws + OFF_WQT);
    float* tile = (float*)smem;
    for (int tl = blockIdx.x; tl < 5632; tl += gridDim.x) {
        const float* src; u16* dst; int ld, kt, nt;
        if (tl < 3584) { src = p.w_in; dst = winT; ld = DIN; kt = tl / 112; nt = tl % 112; }
        else if (tl < 4608) { const int r = tl - 3584; src = p.w_out; dst = woutT; ld = DM; kt = r >> 5; nt = r & 31; }
        else { const int r = tl - 4608; src = p.wq; dst = wqT; ld = DM; kt = r >> 5; nt = r & 31; }
        const int k0 = kt * 64, n0 = nt * 64;
#pragma unroll
        for (int i = 0; i < 2; ++i) {
            const int id = tid + i * 512, r = id >> 4, c4 = (id & 15) * 4;
            const float4 v = *(const float4*)(src + (size_t)(k0 + r) * ld + n0 + c4);
            tile[r * 65 + c4 + 0] = v.x; tile[r * 65 + c4 + 1] = v.y; tile[r * 65 + c4 + 2] = v.z; tile[r * 65 + c4 + 3] = v.w;
        }
        __syncthreads();
        {
            const int n = tid >> 3, k8 = (tid & 7) * 8; float f[8];
#pragma unroll
            for (int j = 0; j < 8; ++j) f[j] = tile[(k8 + j) * 65 + n];
            uint4 w; w.x = pk2(f[0], f[1]); w.y = pk2(f[2], f[3]); w.z = pk2(f[4], f[5]); w.w = pk2(f[6], f[7]);
            *(uint4*)(dst + (size_t)(n0 + n) * 2048 + k0 + k8) = w;
        }
        __syncthreads();
    }
    {
        u16* keyb = (u16*)(p.ws + OFF_KEYB);
        for (int i = blockIdx.x * 512 + tid; i < 65536; i += gridDim.x * 512) {
            const float4 v = *(const float4*)(p.keys + (size_t)i * 4);
            uint2 w; w.x = pk2(v.x, v.y); w.y = pk2(v.z, v.w); *(uint2*)(keyb + (size_t)i * 4) = w;
        }
    }
    {
        u16* ub = (u16*)(p.ws + OFF_UBF); u16* vb = (u16*)(p.ws + OFF_VBF);
        for (int i = blockIdx.x * 512 + tid; i < 4194304; i += gridDim.x * 512) {
            const float4 a = *(const float4*)(p.pu + (size_t)i * 8), b = *(const float4*)(p.pu + (size_t)i * 8 + 4);
            const float4 c = *(const float4*)(p.pv + (size_t)i * 8), d = *(const float4*)(p.pv + (size_t)i * 8 + 4);
            uint4 w; w.x = pk2(a.x, a.y); w.y = pk2(a.z, a.w); w.z = pk2(b.x, b.y); w.w = pk2(b.z, b.w);
            *(uint4*)(ub + (size_t)i * 8) = w;
            uint4 z; z.x = pk2(c.x, c.y); z.y = pk2(c.z, c.w); z.z = pk2(d.x, d.y); z.w = pk2(d.z, d.w);
            *(uint4*)(vb + (size_t)i * 8) = z;
        }
    }
    float* Wg = (float*)smem;
    for (int idx = tid; idx < 32768; idx += 512) { const int k = idx >> 4, g = idx & 15; Wg[g * 2048 + k] = p.w_in[(size_t)k * DIN + NPJ + g]; }
    __syncthreads();
    u16* h0b = (u16*)(p.ws + OFF_H0B); float* gates = (float*)(p.ws + OFF_GATES);
    for (int tok = blockIdx.x * 8 + wave; tok < T_TOK; tok += gridDim.x * 8) {
        float4 xv[8]; const float* xr = p.x + (size_t)tok * DM;
#pragma unroll
        for (int i = 0; i < 8; ++i) xv[i] = *(const float4*)(xr + i * 256 + lane * 4);
        float s = 0.f;
#pragma unroll
        for (int i = 0; i < 8; ++i) s += (xv[i].x + xv[i].y) + (xv[i].z + xv[i].w);
        const float mean = wsum(s) * (1.0f / 2048.0f);
        float q = 0.f;
#pragma unroll
        for (int i = 0; i < 8; ++i) { xv[i].x -= mean; xv[i].y -= mean; xv[i].z -= mean; xv[i].w -= mean; q += xv[i].x * xv[i].x + xv[i].y * xv[i].y + xv[i].z * xv[i].z + xv[i].w * xv[i].w; }
        const float rstd = rsqrtf(wsum(q) * (1.0f / 2048.0f) + LN_EPS_F);
#pragma unroll
        for (int i = 0; i < 8; ++i) {
            const float4 g4 = *(const float4*)(p.ln_in_g + i * 256 + lane * 4), b4 = *(const float4*)(p.ln_in_b + i * 256 + lane * 4);
            xv[i].x = xv[i].x * rstd * g4.x + b4.x; xv[i].y = xv[i].y * rstd * g4.y + b4.y; xv[i].z = xv[i].z * rstd * g4.z + b4.z; xv[i].w = xv[i].w * rstd * g4.w + b4.w;
            uint2 w; w.x = pk2(xv[i].x, xv[i].y); w.y = pk2(xv[i].z, xv[i].w);
            *(uint2*)(h0b + (size_t)tok * DM + i * 256 + lane * 4) = w;
        }
        float part[16];
#pragma unroll
        for (int g = 0; g < 16; ++g) {
            float a = 0.f;
#pragma unroll
            for (int i = 0; i < 8; ++i) { const float4 w4 = *(const float4*)(Wg + g * 2048 + i * 256 + lane * 4); a += xv[i].x * w4.x + xv[i].y * w4.y + xv[i].z * w4.z + xv[i].w * w4.w; }
            part[g] = a;
        }
#pragma unroll
        for (int st = 0; st < 4; ++st) {
            const int sft = 32 >> st, n2 = 8 >> st; const bool up = (lane & sft) != 0;
#pragma unroll
            for (int i = 0; i < n2; ++i) {
                const float a = part[i], b = part[i + n2];
                const float send = up ? a : b, keep = up ? b : a;
                part[i] = keep + __shfl_xor(send, sft);
            }
        }
        float v = part[0]; v += __shfl_xor(v, 2); v += __shfl_xor(v, 1);
        if ((lane & 3) == 0) {
            const int g = ((lane >> 5) & 1) * 8 + ((lane >> 4) & 1) * 4 + ((lane >> 3) & 1) * 2 + ((lane >> 2) & 1);
            float z = v + p.b_gate[g];
            if (g >= 8) z = fminf(z, 0.f) - log1pf(__expf(-fabsf(z)));
            gates[(size_t)tok * 16 + g] = z;
        }
    }
}

__device__ void phase_conv_local(const Params& p, unsigned char* smem) {
    const int tid = threadIdx.x, lane = tid & 63, wave = tid >> 6;
    const u16* proj = (const u16*)(p.ws + OFF_PROJ); u16* ymix = (u16*)(p.ws + OFF_YMIX);
    for (int task = blockIdx.x * 512 + tid; task < 131072; task += gridDim.x * 512) {
        const int cgp = task & 127, run = task >> 7, t0 = run * 32, c0 = cgp * 8;
        float w0[8], w1[8], w2[8], bb[8], z1[8], z2[8];
#pragma unroll
        for (int j = 0; j < 8; ++j) { w0[j] = p.conv_w[c0 + j]; w1[j] = p.conv_w[1024 + c0 + j]; w2[j] = p.conv_w[2048 + c0 + j]; bb[j] = p.conv_b[c0 + j]; z1[j] = 0.f; z2[j] = 0.f; }
        if ((t0 & (SEQ_L - 1)) != 0) {
            float a[8], b[8];
            unpack8(*(const uint4*)(proj + (size_t)(t0 - 2) * NPJ + 1024 + c0), a); unpack8(*(const uint4*)(proj + (size_t)(t0 - 2) * NPJ + 2048 + c0), b);
#pragma unroll
            for (int j = 0; j < 8; ++j) z2[j] = a[j] * b[j];
            unpack8(*(const uint4*)(proj + (size_t)(t0 - 1) * NPJ + 1024 + c0), a); unpack8(*(const uint4*)(proj + (size_t)(t0 - 1) * NPJ + 2048 + c0), b);
#pragma unroll
            for (int j = 0; j < 8; ++j) z1[j] = a[j] * b[j];
        }
        for (int t = t0; t < t0 + 32; ++t) {
            float cb[8], cc[8], ch[8], y[8];
            unpack8(*(const uint4*)(proj + (size_t)t * NPJ + c0), cb); unpack8(*(const uint4*)(proj + (size_t)t * NPJ + 1024 + c0), cc); unpack8(*(const uint4*)(proj + (size_t)t * NPJ + 2048 + c0), ch);
#pragma unroll
            for (int j = 0; j < 8; ++j) { const float z = cc[j] * ch[j]; y[j] = cb[j] * (bb[j] + w0[j] * z2[j] + w1[j] * z1[j] + w2[j] * z); z2[j] = z1[j]; z1[j] = z; }
            uint4 w; w.x = pk2(y[0], y[1]); w.y = pk2(y[2], y[3]); w.z = pk2(y[4], y[5]); w.w = pk2(y[6], y[7]);
            *(uint4*)(ymix + (size_t)t * DM + c0) = w;
        }
    }
    const float* gates = (const float*)(p.ws + OFF_GATES);
    float* dC = p.out; float* dn = (float*)(p.ws + OFF_DN); float* MG = (float*)(p.ws + OFF_MG); float* BL = (float*)(p.ws + OFF_BL);
    u16* KT = (u16*)smem;
    u16* VT = (u16*)(smem + 18432);
    float* wk_s = (float*)(smem + 36864);
    for (int item = blockIdx.x; item < 4096; item += gridDim.x) {
        const int bh = item >> 8, c = item & 255, b = bh >> 3, h = bh & 7;
        const int t0 = b * SEQ_L + c * 64;
        if (wave == 0) {
            const float li = gates[(size_t)(t0 + lane) * 16 + h], lf = gates[(size_t)(t0 + lane) * 16 + 8 + h];
            const float bc = wscan_add(lf, lane);
            const float bL = __shfl(bc, 63);
            const float g = bL - bc + li;
            const float mg = wmaxf(g);
            wk_s[lane] = __expf(g - mg);
            if (lane == 0) { MG[item] = mg; BL[item] = bL; }
        }
        uint4 kv[2], vv[2];
#pragma unroll
        for (int i = 0; i < 2; ++i) {
            const int id = tid + i * 512, l = id >> 4, c8 = (id & 15) * 8;
            kv[i] = *(const uint4*)(proj + (size_t)(t0 + l) * NPJ + 4096 + h * 128 + c8);
            vv[i] = *(const uint4*)(proj + (size_t)(t0 + l) * NPJ + 5120 + h * 128 + c8);
        }
        __syncthreads();
#pragma unroll
        for (int i = 0; i < 2; ++i) {
            const int id = tid + i * 512, l = id >> 4, c8 = (id & 15) * 8;
            const float w = wk_s[l];
            float kf[8], vf[8]; unpack8(kv[i], kf); unpack8(vv[i], vf);
#pragma unroll
            for (int j = 0; j < 8; j += 2) {
                const unsigned kk = pk2(kf[j], kf[j + 1]), vw = pk2(vf[j] * w, vf[j + 1] * w);
                KT[(c8 + j) * 72 + l] = (u16)(kk & 0xffffu); KT[(c8 + j + 1) * 72 + l] = (u16)(kk >> 16);
                VT[(c8 + j) * 72 + l] = (u16)(vw & 0xffffu); VT[(c8 + j + 1) * 72 + l] = (u16)(vw >> 16);
            }
        }
        __syncthreads();
        {
            const int fr = lane & 15, fq = lane >> 4, e0 = wave * 16;
            bf16x8 bfr[2];
#pragma unroll
            for (int kk = 0; kk < 2; ++kk) bfr[kk] = *(const bf16x8*)(VT + (e0 + fr) * 72 + kk * 32 + fq * 8);
            float* dst = dC + (size_t)item * 16384 + (size_t)(e0 + fr) * 128 + fq * 4;
#pragma unroll
            for (int dt = 0; dt < 8; ++dt) {
                f32x4 acc = {0.f, 0.f, 0.f, 0.f};
#pragma unroll
                for (int kk = 0; kk < 2; ++kk) {
                    const bf16x8 afr = *(const bf16x8*)(KT + (dt * 16 + fr) * 72 + kk * 32 + fq * 8);
                    acc = __builtin_amdgcn_mfma_f32_16x16x32_bf16(afr, bfr[kk], acc, 0, 0, 0);
                }
                acc *= QK_SCALE;
                *(f32x4*)(dst + dt * 16) = acc;
            }
        }
        if (tid < 128) {
            float a = 0.f;
#pragma unroll
            for (int l8 = 0; l8 < 8; ++l8) {
                float kf[8]; unpack8(*(const uint4*)(KT + tid * 72 + l8 * 8), kf);
#pragma unroll
                for (int j = 0; j < 8; ++j) a += kf[j] * wk_s[l8 * 8 + j];
            }
            dn[(size_t)item * 128 + tid] = a * QK_SCALE;
        }
        __syncthreads();
    }
}

__device__ void phase_scan(const Params& p) {
    const int tid = threadIdx.x;
    float* dC = p.out; float* dn = (float*)(p.ws + OFF_DN);
    const float* MG = (const float*)(p.ws + OFF_MG); const float* BL = (const float*)(p.ws + OFF_BL); float* MST = (float*)(p.ws + OFF_MST);
    for (int s = blockIdx.x * 512 + tid; s < 16 * 16512; s += gridDim.x * 512) {
        const int bh = s / 16512, idx = s - bh * 16512;
        float* ptr; size_t stride;
        if (idx < 16384) { ptr = dC + (size_t)bh * 256 * 16384 + idx; stride = 16384; } else { ptr = dn + (size_t)bh * 256 * 128 + (idx - 16384); stride = 128; }
        float m = 0.f, st = 0.f;
        for (int c = 0; c < 256; c += 8) {
            float d[8];
#pragma unroll
            for (int j = 0; j < 8; ++j) d[j] = ptr[(size_t)(c + j) * stride];
#pragma unroll
            for (int j = 0; j < 8; ++j) {
                const float mg = MG[bh * 256 + c + j], bL = BL[bh * 256 + c + j];
                const float mn = fmaxf(bL + m, mg);
                st = __expf(bL + m - mn) * st + __expf(mg - mn) * d[j];
                ptr[(size_t)(c + j) * stride] = st;
                m = mn;
                if (idx == 0) MST[bh * 256 + c + j] = mn;
            }
        }
    }
}

__device__ void phase_mlstm_out(const Params& p, unsigned char* smem) {
    const int tid = threadIdx.x, lane = tid & 63, wave = tid >> 6;
    const u16* proj = (const u16*)(p.ws + OFF_PROJ); u16* ymix = (u16*)(p.ws + OFF_YMIX);
    const float* gates = (const float*)(p.ws + OFF_GATES);
    const float* Cst = p.out; const float* nst = (const float*)(p.ws + OFF_DN); const float* MST = (const float*)(p.ws + OFF_MST);
    u16* Qs = (u16*)smem;
    u16* Ks = (u16*)(smem + 17408);
    u16* VT = (u16*)(smem + 34816);
    u16* Cb = (u16*)(smem + 53248);
    u16* Ss = (u16*)(smem + 88064);
    float* fa = (float*)(smem + 97280);
    float* a_s = fa, *mm_s = fa + 64, *wi_s = fa + 128, *emt_s = fa + 192, *den_s = fa + 256, *nq_s = fa + 320, *sum_s = fa + 384, *sq_s = fa + 448, *n_s = fa + 512;
    const int fr = lane & 15, fq = lane >> 4;
    for (int item = blockIdx.x; item < 4096; item += gridDim.x) {
        const int bh = item >> 8, c = item & 255, b = bh >> 3, h = bh & 7;
        const int t0 = b * SEQ_L + c * 64;
        if (wave == 0) {
            const float li = gates[(size_t)(t0 + lane) * 16 + h], lf = gates[(size_t)(t0 + lane) * 16 + 8 + h];
            const float bc = wscan_add(lf, lane);
            const float a = li - bc;
            const float pm = wscan_max(a, lane);
            const float mprev = (c > 0) ? MST[item - 1] : 0.f;
            const float mm = fmaxf(mprev, pm);
            a_s[lane] = a; mm_s[lane] = mm; wi_s[lane] = __expf(mprev - mm); emt_s[lane] = __expf(-(bc + mm));
            den_s[lane] = 0.f; sum_s[lane] = 0.f; sq_s[lane] = 0.f;
        }
#pragma unroll
        for (int i = 0; i < 2; ++i) {
            const int id = tid + i * 512, l = id >> 4, c8 = (id & 15) * 8;
            const uint4 qv = *(const uint4*)(proj + (size_t)(t0 + l) * NPJ + 3072 + h * 128 + c8);
            const uint4 kv = *(const uint4*)(proj + (size_t)(t0 + l) * NPJ + 4096 + h * 128 + c8);
            const uint4 vv = *(const uint4*)(proj + (size_t)(t0 + l) * NPJ + 5120 + h * 128 + c8);
            *(uint4*)(Qs + l * 136 + c8) = qv; *(uint4*)(Ks + l * 136 + c8) = kv;
            const unsigned vw[4] = {vv.x, vv.y, vv.z, vv.w};
#pragma unroll
            for (int j = 0; j < 4; ++j) { VT[(c8 + 2 * j) * 72 + l] = (u16)(vw[j] & 0xffffu); VT[(c8 + 2 * j + 1) * 72 + l] = (u16)(vw[j] >> 16); }
        }
        if (c > 0) {
            const float* Cp = Cst + (size_t)(item - 1) * 16384;
#pragma unroll
            for (int i = 0; i < 4; ++i) {
                const int id = tid + i * 512, e = id >> 4, d8 = (id & 15) * 8;
                const float4 x0 = *(const float4*)(Cp + e * 128 + d8), x1 = *(const float4*)(Cp + e * 128 + d8 + 4);
                uint4 w; w.x = pk2(x0.x, x0.y); w.y = pk2(x0.z, x0.w); w.z = pk2(x1.x, x1.y); w.w = pk2(x1.z, x1.w);
                *(uint4*)(Cb + e * 136 + d8) = w;
            }
            if (tid < 128) n_s[tid] = nst[(size_t)(item - 1) * 128 + tid];
        } else {
#pragma unroll
            for (int i = 0; i < 4; ++i) { const int id = tid + i * 512, e = id >> 4, d8 = (id & 15) * 8; *(uint4*)(Cb + e * 136 + d8) = make_uint4(0u, 0u, 0u, 0u); }
            if (tid < 128) n_s[tid] = 0.f;
        }
        __syncthreads();
        {
            const int lt = wave >> 1, l = lt * 16 + fr; const float mml = mm_s[l];
#pragma unroll
            for (int jj = 0; jj < 2; ++jj) {
                const int jt = (wave & 1) * 2 + jj, j0 = jt * 16 + fq * 4;
                float sv[4] = {0.f, 0.f, 0.f, 0.f};
                if (jt <= lt) {
                    f32x4 acc = {0.f, 0.f, 0.f, 0.f};
#pragma unroll
                    for (int kk = 0; kk < 4; ++kk) {
                        const bf16x8 afr = *(const bf16x8*)(Ks + (jt * 16 + fr) * 136 + kk * 32 + fq * 8);
                        const bf16x8 bfr = *(const bf16x8*)(Qs + (lt * 16 + fr) * 136 + kk * 32 + fq * 8);
                        acc = __builtin_amdgcn_mfma_f32_16x16x32_bf16(afr, bfr, acc, 0, 0, 0);
                    }
#pragma unroll
                    for (int r = 0; r < 4; ++r) { const int j = j0 + r; sv[r] = (j <= l) ? acc[r] * QK_SCALE * __expf(a_s[j] - mml) : 0.f; }
                }
                float rs = (sv[0] + sv[1]) + (sv[2] + sv[3]);
                rs += __shfl_xor(rs, 16); rs += __shfl_xor(rs, 32);
                if (fq == 0 && jt <= lt) atomicAdd(&den_s[l], rs);
                uint2 w; w.x = pk2(sv[0], sv[1]); w.y = pk2(sv[2], sv[3]);
                *(uint2*)(Ss + l * 72 + j0) = w;
            }
        }
        {
            const int l = tid >> 3, d0 = (tid & 7) * 16; float a = 0.f;
#pragma unroll
            for (int u = 0; u < 2; ++u) {
                float qf[8]; unpack8(*(const uint4*)(Qs + l * 136 + d0 + u * 8), qf);
#pragma unroll
                for (int j = 0; j < 8; ++j) a += qf[j] * n_s[d0 + u * 8 + j];
            }
            a += __shfl_xor(a, 1); a += __shfl_xor(a, 2); a += __shfl_xor(a, 4);
            if ((tid & 7) == 0) nq_s[l] = a;
        }
        __syncthreads();
        float hv[4][4];
        {
            const int e0 = wave * 16;
            bf16x8 av[2], ac[4];
#pragma unroll
            for (int kk = 0; kk < 2; ++kk) av[kk] = *(const bf16x8*)(VT + (e0 + fr) * 72 + kk * 32 + fq * 8);
#pragma unroll
            for (int kk = 0; kk < 4; ++kk) ac[kk] = *(const bf16x8*)(Cb + (e0 + fr) * 136 + kk * 32 + fq * 8);
#pragma unroll
            for (int lt = 0; lt < 4; ++lt) {
                const int l = lt * 16 + fr;
                f32x4 a1 = {0.f, 0.f, 0.f, 0.f}, a2 = {0.f, 0.f, 0.f, 0.f};
#pragma unroll
                for (int kk = 0; kk < 2; ++kk) { const bf16x8 bs = *(const bf16x8*)(Ss + l * 72 + kk * 32 + fq * 8); a1 = __builtin_amdgcn_mfma_f32_16x16x32_bf16(av[kk], bs, a1, 0, 0, 0); }
#pragma unroll
                for (int kk = 0; kk < 4; ++kk) { const bf16x8 bq = *(const bf16x8*)(Qs + l * 136 + kk * 32 + fq * 8); a2 = __builtin_amdgcn_mfma_f32_16x16x32_bf16(ac[kk], bq, a2, 0, 0, 0); }
                const float wi = wi_s[l];
                const float den = den_s[l] + wi * nq_s[l];
                const float inv = 1.0f / fmaxf(fabsf(den), emt_s[l]);
                float s1 = 0.f, s2 = 0.f;
#pragma unroll
                for (int r = 0; r < 4; ++r) { const float hh = (a1[r] + wi * a2[r]) * inv; hv[lt][r] = hh; s1 += hh; s2 += hh * hh; }
                s1 += __shfl_xor(s1, 16); s1 += __shfl_xor(s1, 32); s2 += __shfl_xor(s2, 16); s2 += __shfl_xor(s2, 32);
                if (fq == 0) { atomicAdd(&sum_s[l], s1); atomicAdd(&sq_s[l], s2); }
            }
        }
        __syncthreads();
        {
            const int e = wave * 16 + fq * 4;
            const float4 gn = *(const float4*)(p.mh_g + h * 128 + e);
#pragma unroll
            for (int lt = 0; lt < 4; ++lt) {
                const int l = lt * 16 + fr;
                const float mean = sum_s[l] * (1.0f / 128.0f);
                const float var = fmaxf(sq_s[l] * (1.0f / 128.0f) - mean * mean, 0.f);
                const float rstd = rsqrtf(var + LN_EPS_F);
                const uint2 ow = *(const uint2*)(proj + (size_t)(t0 + l) * NPJ + 6144 + h * 128 + e);
                const float o0 = bflo(ow.x), o1 = bfhi(ow.x), o2 = bflo(ow.y), o3 = bfhi(ow.y);
                const float y0 = (hv[lt][0] - mean) * rstd * gn.x / (1.0f + __expf(-o0));
                const float y1 = (hv[lt][1] - mean) * rstd * gn.y / (1.0f + __expf(-o1));
                const float y2 = (hv[lt][2] - mean) * rstd * gn.z / (1.0f + __expf(-o2));
                const float y3 = (hv[lt][3] - mean) * rstd * gn.w / (1.0f + __expf(-o3));
                uint2 w; w.x = pk2(y0, y1); w.y = pk2(y2, y3);
                *(uint2*)(ymix + (size_t)(t0 + l) * DM + 1024 + h * 128 + e) = w;
            }
        }
        __syncthreads();
    }
}

struct EpiPre {
    static constexpr bool PERM = false, AFTER_DRAIN = false;
    float* C; const u16* h0;
    __device__ __forceinline__ void operator()(const f32x4 (&acc)[2][2][4][2], const pg8::Unit& u, int wr, int wc, int fr, int fq) const {
        const int row0 = u.pm * 256 + wr * 64 + fr, col0 = u.pn * 256 + wc * 32 + 4 * fq;
#pragma unroll
        for (int ai = 0; ai < 2; ++ai)
#pragma unroll
            for (int m = 0; m < 4; ++m) {
                const size_t ro = (size_t)(row0 + ai * 128 + m * 16) * DM + col0;
#pragma unroll
                for (int bj = 0; bj < 2; ++bj)
#pragma unroll
                    for (int n = 0; n < 2; ++n) {
                        const uint2 hb = *(const uint2*)(h0 + ro + bj * 128 + n * 16);
                        f32x4 r = acc[ai][bj][m][n];
                        r[0] += ALPHA_F * bflo(hb.x); r[1] += ALPHA_F * bfhi(hb.x); r[2] += ALPHA_F * bflo(hb.y); r[3] += ALPHA_F * bfhi(hb.y);
                        *(f32x4*)(C + ro + bj * 128 + n * 16) = r;
                    }
            }
    }
};

__device__ void phase_ln1(const Params& p) {
    const int tid = threadIdx.x, lane = tid & 63, wave = tid >> 6;
    u16* h1b = (u16*)(p.ws + OFF_H1B);
    for (int tok = blockIdx.x * 8 + wave; tok < T_TOK; tok += gridDim.x * 8) {
        float4 xv[8]; float* xr = p.out + (size_t)tok * DM;
#pragma unroll
        for (int i = 0; i < 8; ++i) xv[i] = *(const float4*)(xr + i * 256 + lane * 4);
        float s = 0.f;
#pragma unroll
        for (int i = 0; i < 8; ++i) s += (xv[i].x + xv[i].y) + (xv[i].z + xv[i].w);
        const float mean = wsum(s) * (1.0f / 2048.0f);
        float q = 0.f;
#pragma unroll
        for (int i = 0; i < 8; ++i) { xv[i].x -= mean; xv[i].y -= mean; xv[i].z -= mean; xv[i].w -= mean; q += xv[i].x * xv[i].x + xv[i].y * xv[i].y + xv[i].z * xv[i].z + xv[i].w * xv[i].w; }
        const float rstd = rsqrtf(wsum(q) * (1.0f / 2048.0f) + LN_EPS_F);
#pragma unroll
        for (int i = 0; i < 8; ++i) {
            const float4 g4 = *(const float4*)(p.ln1_g + i * 256 + lane * 4), b4 = *(const float4*)(p.ln1_b + i * 256 + lane * 4);
            float4 y; y.x = xv[i].x * rstd * g4.x + b4.x; y.y = xv[i].y * rstd * g4.y + b4.y; y.z = xv[i].z * rstd * g4.z + b4.z; y.w = xv[i].w * rstd * g4.w + b4.w;
            *(float4*)(xr + i * 256 + lane * 4) = y;
            uint2 w; w.x = pk2(y.x, y.y); w.y = pk2(y.z, y.w);
            *(uint2*)(h1b + (size_t)tok * DM + i * 256 + lane * 4) = w;
        }
    }
}

__device__ __forceinline__ int f2key(float f) { const int b = __float_as_int(f); return b ^ ((b >> 31) & 0x7fffffff); }
__device__ __forceinline__ float key2f(int k) { return __int_as_float(k ^ ((k >> 31) & 0x7fffffff)); }
__device__ __forceinline__ void ce_desc(int& a, int& b) { const int hi = max(a, b), lo = min(a, b); a = hi; b = lo; }
template <int OFF> __device__ __forceinline__ void sort16_desc(int (&v)[64]) {
#pragma unroll
    for (int k = 2; k <= 16; k <<= 1)
#pragma unroll
        for (int j = k >> 1; j > 0; j >>= 1)
#pragma unroll
            for (int i = 0; i < 16; ++i) { const int l = i ^ j; if (l > i) { if ((i & k) == 0) ce_desc(v[OFF + i], v[OFF + l]); else ce_desc(v[OFF + l], v[OFF + i]); } }
}
template <int OA, int OB> __device__ __forceinline__ void merge16_desc(int (&v)[64]) {
#pragma unroll
    for (int i = 0; i < 16; ++i) v[OA + i] = max(v[OA + i], v[OB + 15 - i]);
#pragma unroll
    for (int j = 8; j > 0; j >>= 1)
#pragma unroll
        for (int i = 0; i < 16; ++i) { const int l = i ^ j; if (l > i) ce_desc(v[OA + i], v[OA + l]); }
}
__device__ __forceinline__ void top16_of_64(int (&v)[64]) {
    sort16_desc<0>(v); sort16_desc<16>(v); sort16_desc<32>(v); sort16_desc<48>(v);
    merge16_desc<0, 16>(v); merge16_desc<32, 48>(v); merge16_desc<0, 32>(v);
}

__device__ void phase_select(const Params& p, unsigned char* smem) {
    const int tid = threadIdx.x, lane = tid & 63, wave = tid >> 6;
    const u16* qb = (const u16*)(p.ws + OFF_QB); const u16* keyb = (const u16*)(p.ws + OFF_KEYB);
    int* eidp = (int*)(p.ws + OFF_EID); float* gwp = (float*)(p.ws + OFF_GW);
    unsigned char* lut = smem + wave * 2048 + lane * 32;
    const int col = lane & 31, hi = lane >> 5;
    for (int wi = blockIdx.x * 8 + wave; wi < 8192; wi += gridDim.x * 8) {
        const int tile = wi >> 3, h = wi & 7, t0 = tile * 32;
        int sv[2][16];
#pragma unroll
        for (int pp = 0; pp < 2; ++pp) {
            f32x16 acc[4];
#pragma unroll
            for (int mt = 0; mt < 4; ++mt)
#pragma unroll
                for (int r = 0; r < 16; ++r) acc[mt][r] = 0.f;
            const u16* kb = keyb + (size_t)((h * 2 + pp) * 128) * 128;
            const u16* qrow = qb + (size_t)(t0 + col) * DM + h * 256 + pp * 128;
#pragma unroll 2
            for (int kk = 0; kk < 8; ++kk) {
                const bf16x8 bq = *(const bf16x8*)(qrow + kk * 16 + hi * 8);
#pragma unroll
                for (int mt = 0; mt < 4; ++mt) {
                    const bf16x8 ak = *(const bf16x8*)(kb + (size_t)(mt * 32 + col) * 128 + kk * 16 + hi * 8);
                    acc[mt] = __builtin_amdgcn_mfma_f32_32x32x16_bf16(ak, bq, acc[mt], 0, 0, 0);
                }
            }
            int v[64];
#pragma unroll
            for (int mt = 0; mt < 4; ++mt)
#pragma unroll
                for (int r = 0; r < 16; ++r) { const int n = 32 * mt + 8 * (r >> 2) + (r & 3) + 4 * hi; v[mt * 16 + r] = (f2key(acc[mt][r]) & ~127) | n; }
            top16_of_64(v);
#pragma unroll
            for (int i = 0; i < 16; ++i) v[16 + i] = __shfl_xor(v[i], 32);
            merge16_desc<0, 16>(v);
#pragma unroll
            for (int i = 0; i < 16; ++i) sv[pp][i] = v[i];
        }
        float f0[16], f1[16];
#pragma unroll
        for (int i = 0; i < 16; ++i) { f0[i] = key2f(sv[0][i] & ~127); f1[i] = key2f(sv[1][i] & ~127); lut[i] = (unsigned char)(sv[0][i] & 127); lut[16 + i] = (unsigned char)(sv[1][i] & 127); }
        int v[64]; int cnt = 0;
#pragma unroll
        for (int a = 0; a < 16; ++a)
#pragma unroll
            for (int b = 0; b < 16; ++b)
                if ((a + 1) * (b + 1) <= 16) { v[cnt] = (f2key(f0[a] + f1[b]) & ~255) | (a * 16 + b); ++cnt; }
#pragma unroll
        for (int i = 50; i < 64; ++i) v[i] = f2key(-1e30f);
        top16_of_64(v);
        float ev[16]; float ssum = 0.f; const float mx = key2f(v[0] & ~255);
#pragma unroll
        for (int k = 0; k < 16; ++k) { ev[k] = __expf(key2f(v[k] & ~255) - mx); ssum += ev[k]; }
        const float inv = 1.0f / ssum;
        const size_t ob = ((size_t)(t0 + col) * 8 + h) * 16;
#pragma unroll
        for (int k = 0; k < 16; ++k) {
            const int code = v[k] & 255;
            const int i0 = lut[code >> 4], i1 = lut[16 + (code & 15)];
            if ((k >> 3) == hi) { eidp[ob + k] = i0 * 128 + i1; gwp[ob + k] = ev[k] * inv; }
        }
    }
}

__device__ void phase_experts(const Params& p) {
    const int tid = threadIdx.x, lane = tid & 63, wave = tid >> 6;
    const u16* h1b = (const u16*)(p.ws + OFF_H1B); const u16* ub = (const u16*)(p.ws + OFF_UBF); const u16* vb = (const u16*)(p.ws + OFF_VBF);
    const int* eidp = (const int*)(p.ws + OFF_EID); const float* gwp = (const float*)(p.ws + OFF_GW);
    for (int tok = blockIdx.x * 8 + wave; tok < T_TOK; tok += gridDim.x * 8) {
        float xf[32], acc[32];
#pragma unroll
        for (int i = 0; i < 4; ++i) {
            float t[8]; unpack8(*(const uint4*)(h1b + (size_t)tok * DM + i * 512 + lane * 8), t);
#pragma unroll
            for (int j = 0; j < 8; ++j) { xf[i * 8 + j] = t[j]; acc[i * 8 + j] = 0.f; }
        }
#pragma unroll 1
        for (int half = 0; half < 2; ++half) {
            const int ev = eidp[(size_t)tok * 128 + half * 64 + lane];
            const int gv = __float_as_int(gwp[(size_t)tok * 128 + half * 64 + lane]);
#pragma unroll 1
            for (int j = 0; j < 64; j += 4) {
                int e[4]; float g[4], part[4];
#pragma unroll
                for (int q = 0; q < 4; ++q) { e[q] = __builtin_amdgcn_readlane(ev, j + q); g[q] = __int_as_float(__builtin_amdgcn_readlane(gv, j + q)); }
#pragma unroll
                for (int q = 0; q < 4; ++q) {
                    const u16* ur = ub + (size_t)e[q] * DM + lane * 8; float a = 0.f;
#pragma unroll
                    for (int i = 0; i < 4; ++i) {
                        float t[8]; unpack8(*(const uint4*)(ur + i * 512), t);
#pragma unroll
                        for (int jj = 0; jj < 8; ++jj) a += t[jj] * xf[i * 8 + jj];
                    }
                    part[q] = a;
                }
                {
                    const bool up5 = (lane & 32) != 0, up4 = (lane & 16) != 0;
                    const float s0 = up5 ? part[0] : part[2], k0 = up5 ? part[2] : part[0];
                    const float s1 = up5 ? part[1] : part[3], k1 = up5 ? part[3] : part[1];
                    const float r0 = k0 + __shfl_xor(s0, 32), r1 = k1 + __shfl_xor(s1, 32);
                    const float s2 = up4 ? r0 : r1, k2 = up4 ? r1 : r0;
                    float r = k2 + __shfl_xor(s2, 16);
                    r += __shfl_xor(r, 8); r += __shfl_xor(r, 4); r += __shfl_xor(r, 2); r += __shfl_xor(r, 1);
                    const float ge = 0.5f * r * (1.0f + erff(r * 0.70710678118654752f));
                    const int gi = __float_as_int(ge);
#pragma unroll
                    for (int q = 0; q < 4; ++q) part[q] = g[q] * __int_as_float(__builtin_amdgcn_readlane(gi, 32 * (q >> 1) + 16 * (q & 1)));
                }
#pragma unroll
                for (int q = 0; q < 4; ++q) {
                    const u16* vr = vb + (size_t)e[q] * DM + lane * 8; const float w = part[q];
#pragma unroll
                    for (int i = 0; i < 4; ++i) {
                        float t[8]; unpack8(*(const uint4*)(vr + i * 512), t);
#pragma unroll
                        for (int jj = 0; jj < 8; ++jj) acc[i * 8 + jj] += w * t[jj];
                    }
                }
            }
        }
        float* orow = p.out + (size_t)tok * DM;
        float s = 0.f;
#pragma unroll
        for (int i = 0; i < 4; ++i) {
            const float4 a = *(const float4*)(orow + i * 512 + lane * 8), b = *(const float4*)(orow + i * 512 + lane * 8 + 4);
            acc[i * 8 + 0] += ALPHA_F * a.x; acc[i * 8 + 1] += ALPHA_F * a.y; acc[i * 8 + 2] += ALPHA_F * a.z; acc[i * 8 + 3] += ALPHA_F * a.w;
            acc[i * 8 + 4] += ALPHA_F * b.x; acc[i * 8 + 5] += ALPHA_F * b.y; acc[i * 8 + 6] += ALPHA_F * b.z; acc[i * 8 + 7] += ALPHA_F * b.w;
        }
#pragma unroll
        for (int i = 0; i < 32; ++i) s += acc[i];
        const float mean = wsum(s) * (1.0f / 2048.0f);
        float q = 0.f;
#pragma unroll
        for (int i = 0; i < 32; ++i) { acc[i] -= mean; q += acc[i] * acc[i]; }
        const float rstd = rsqrtf(wsum(q) * (1.0f / 2048.0f) + LN_EPS_F);
#pragma unroll
        for (int i = 0; i < 4; ++i) {
            const float4 g0 = *(const float4*)(p.ln2_g + i * 512 + lane * 8), g1 = *(const float4*)(p.ln2_g + i * 512 + lane * 8 + 4);
            const float4 b0 = *(const float4*)(p.ln2_b + i * 512 + lane * 8), b1 = *(const float4*)(p.ln2_b + i * 512 + lane * 8 + 4);
            float4 y0, y1;
            y0.x = acc[i * 8 + 0] * rstd * g0.x + b0.x; y0.y = acc[i * 8 + 1] * rstd * g0.y + b0.y; y0.z = acc[i * 8 + 2] * rstd * g0.z + b0.z; y0.w = acc[i * 8 + 3] * rstd * g0.w + b0.w;
            y1.x = acc[i * 8 + 4] * rstd * g1.x + b1.x; y1.y = acc[i * 8 + 5] * rstd * g1.y + b1.y; y1.z = acc[i * 8 + 6] * rstd * g1.z + b1.z; y1.w = acc[i * 8 + 7] * rstd * g1.w + b1.w;
            *(float4*)(orow + i * 512 + lane * 8) = y0; *(float4*)(orow + i * 512 + lane * 8 + 4) = y1;
        }
    }
}

__global__ __launch_bounds__(512, 2) void mega(Params p, int lo, int hi) {
    extern __shared__ __attribute__((aligned(16))) unsigned char smem[];
    cg::grid_group grid = cg::this_grid();
#define PH_BEGIN(i) if ((i) >= lo && (i) < hi) {
#define PH_END(i) } if ((i) + 1 > lo && (i) + 1 < hi) grid.sync();
    PH_BEGIN(0) phase_prep(p, smem); PH_END(0)
    PH_BEGIN(1) {
        pg8::Gemm g{(const pg8::bf16_t*)(p.ws + OFF_H0B), (const pg8::bf16_t*)(p.ws + OFF_WINT), T_TOK, NPJ, DM};
        pg8::StaticOrder S; S.init(g.M, g.N, (int)gridDim.x, (int)blockIdx.x);
        pg8::EpiBf16<0> E{(pg8::bf16_t*)(p.ws + OFF_PROJ), NPJ, nullptr, 0, 0};
        pg8::gemm_phase<pg8::EpiBf16<0>, pg8::StaticOrder, false>((PG8_LAS unsigned char*)smem, g, S, E, nullptr);
    } PH_END(1)
    PH_BEGIN(2) phase_conv_local(p, smem); PH_END(2)
    PH_BEGIN(3) phase_scan(p); PH_END(3)
    PH_BEGIN(4) phase_mlstm_out(p, smem); PH_END(4)
    PH_BEGIN(5) {
        pg8::Gemm g{(const pg8::bf16_t*)(p.ws + OFF_YMIX), (const pg8::bf16_t*)(p.ws + OFF_WOUTT), T_TOK, DM, DM};
        pg8::StaticOrder S; S.init(g.M, g.N, (int)gridDim.x, (int)blockIdx.x);
        EpiPre E{p.out, (const u16*)(p.ws + OFF_H0B)};
        pg8::gemm_phase<EpiPre, pg8::StaticOrder, false>((PG8_LAS unsigned char*)smem, g, S, E, nullptr);
    } PH_END(5)
    PH_BEGIN(6) phase_ln1(p); PH_END(6)
    PH_BEGIN(7) {
        pg8::Gemm g{(const pg8::bf16_t*)(p.ws + OFF_H1B), (const pg8::bf16_t*)(p.ws + OFF_WQT), T_TOK, DM, DM};
        pg8::StaticOrder S; S.init(g.M, g.N, (int)gridDim.x, (int)blockIdx.x);
        pg8::EpiBf16<0> E{(pg8::bf16_t*)(p.ws + OFF_QB), DM, nullptr, 0, 0};
        pg8::gemm_phase<pg8::EpiBf16<0>, pg8::StaticOrder, false>((PG8_LAS unsigned char*)smem, g, S, E, nullptr);
    } PH_END(7)
    PH_BEGIN(8) phase_select(p, smem); PH_END(8)
    PH_BEGIN(9) phase_experts(p); PH_END(9)
}

#define LDS_BYTES 131072
extern "C" void kernel_launch(void* const* d_in, const int* in_sizes, int n_in, void* d_out, int out_size, void* d_ws, size_t ws_size, hipStream_t stream) {
    static int grid_blocks = 0;
    if (!grid_blocks) {
        hipFuncSetAttribute((const void*)mega, hipFuncAttributeMaxDynamicSharedMemorySize, LDS_BYTES);
        int dev = 0, cus = 0, per_cu = 0;
        hipGetDevice(&dev);
        hipDeviceGetAttribute(&cus, hipDeviceAttributeMultiprocessorCount, dev);
        hipOccupancyMaxActiveBlocksPerMultiprocessor(&per_cu, mega, 512, LDS_BYTES);
        if (per_cu < 1) per_cu = 1;
        grid_blocks = cus * per_cu;
        if (grid_blocks > 256) grid_blocks = 256;
    }
    if (ws_size < (size_t)1011 * 1024 * 1024) { fprintf(stderr, "workspace too small: %zu\n", ws_size); return; }
    Params p{};
    p.x = (const float*)d_in[0]; p.ln_in_g = (const float*)d_in[1]; p.ln_in_b = (const float*)d_in[2]; p.w_in = (const float*)d_in[3]; p.b_gate = (const float*)d_in[4];
    p.conv_w = (const float*)d_in[5]; p.conv_b = (const float*)d_in[6]; p.mh_g = (const float*)d_in[7]; p.w_out = (const float*)d_in[8]; p.ln1_g = (const float*)d_in[9]; p.ln1_b = (const float*)d_in[10];
    p.wq = (const float*)d_in[11]; p.keys = (const float*)d_in[12]; p.pu = (const float*)d_in[13]; p.pv = (const float*)d_in[14]; p.ln2_g = (const float*)d_in[15]; p.ln2_b = (const float*)d_in[16];
    p.out = (float*)d_out; p.ws = (unsigned char*)d_ws;
#ifdef MULTI_LAUNCH
    for (int i = 0; i < 10; ++i) { hipLaunchKernelGGL(mega, dim3(grid_blocks), dim3(512), LDS_BYTES, stream, p, i, i + 1); }
#else
    int lo = 0, hi = 10;
    void* args[] = {&p, &lo, &hi};
    hipError_t e = hipLaunchCooperativeKernel((void*)mega, dim3(grid_blocks), dim3(512), args, LDS_BYTES, stream);
    if (e != hipSuccess) fprintf(stderr, "cooperative launch failed: %s (grid %d)\n", hipGetErrorString(e), grid_blocks);
#endif
}
```

```cpp
#include <hip/hip_runtime.h>
#include <hip/hip_cooperative_groups.h>
#include <cstdio>
namespace cg = cooperative_groups;

typedef unsigned short u16;
typedef float f32x16 __attribute__((ext_vector_type(16)));
typedef float f32x2 __attribute__((ext_vector_type(2)));

#define T_TOK 32768
#define SEQ_L 16384
#define DM 2048
#define DIN 7184
#define NPJ 7168
#define ALPHA_F 1.189207115002721f
#define LN_EPS_F 1e-5f
#define QK_SCALE 0.08838834764831845f
#define SLICE_BYTES ((size_t)16384 * 128)

#define MIB ((size_t)1 << 20)
#define OFF_H0B   (0 * MIB)
#define OFF_PROJ  (128 * MIB)
#define OFF_YMIX  (576 * MIB)
#define OFF_H1B   (704 * MIB)
#define OFF_WINT  (832 * MIB)
#define OFF_WOUTT (860 * MIB)
#define OFF_WQT   (868 * MIB)
#define OFF_KEYB  (876 * MIB)
#define OFF_UBF   (877 * MIB)
#define OFF_VBF   (941 * MIB)
#define OFF_GATES (1005 * MIB)
#define OFF_DN    (1007 * MIB)
#define OFF_MG    (1009 * MIB)
#define OFF_BL    (1009 * MIB + 65536)
#define OFF_MST   (1009 * MIB + 131072)
#define OFF_USC   (1009 * MIB + 196608)
#define OFF_VSC   (1009 * MIB + 262144)
#define OFF_LNS   (1009 * MIB + 327680)
#define OFF_XSC   (1009 * MIB + 589824)
#define OFF_BAR   (1010 * MIB)
#define OFF_QB    (128 * MIB)
#define OFF_EID   (256 * MIB)
#define OFF_GW    (272 * MIB)
#define OFF_MIXB  (288 * MIB)
#define OFF_H1F8  (416 * MIB)

struct Params {
    const float *x, *ln_in_g, *ln_in_b, *w_in, *b_gate, *conv_w, *conv_b, *mh_g, *w_out, *ln1_g, *ln1_b, *wq, *keys, *pu, *pv, *ln2_g, *ln2_b;
    float* out; unsigned char* ws;
};

__device__ __forceinline__ unsigned pk2(float lo, float hi) { unsigned r; asm("v_cvt_pk_bf16_f32 %0, %1, %2" : "=v"(r) : "v"(lo), "v"(hi)); return r; }
__device__ __forceinline__ float bflo(unsigned w) { return __uint_as_float(w << 16); }
__device__ __forceinline__ float bfhi(unsigned w) { return __uint_as_float(w & 0xffff0000u); }
__device__ __forceinline__ float bf1(u16 b) { return __uint_as_float(((unsigned)b) << 16); }
__device__ __forceinline__ void unpack8(const uint4 w, float (&f)[8]) {
    f[0] = bflo(w.x); f[1] = bfhi(w.x); f[2] = bflo(w.y); f[3] = bfhi(w.y); f[4] = bflo(w.z); f[5] = bfhi(w.z); f[6] = bflo(w.w); f[7] = bfhi(w.w);
}
__device__ __forceinline__ float wsum(float v) {
#pragma unroll
    for (int o = 32; o; o >>= 1) v += __shfl_xor(v, o);
    return v;
}
__device__ __forceinline__ float wmaxf(float v) {
#pragma unroll
    for (int o = 32; o; o >>= 1) v = fmaxf(v, __shfl_xor(v, o));
    return v;
}
__device__ __forceinline__ float wscan_add(float v, int lane) {
#pragma unroll
    for (int o = 1; o < 64; o <<= 1) { const float t = __shfl_up(v, o); if (lane >= o) v += t; }
    return v;
}
__device__ __forceinline__ float wscan_max(float v, int lane) {
#pragma unroll
    for (int o = 1; o < 64; o <<= 1) { const float t = __shfl_up(v, o); if (lane >= o) v = fmaxf(v, t); }
    return v;
}
#ifndef PROBE_DUP
#define PROBE_DUP -1
#endif
#define XB_TMO      128
#define XB_XCNT(j)  (256  + 64 * (j))
#define XB_XSUB(j)  (1280 + 64 * (j))
#define XB_XGEN(j)  (2304 + 64 * (j))
#define XB_TOP      3328
#define XB_TOPGEN   3392
#define XCD_BAR_WORDS 3456
#define XB_SPIN_CAP (1u << 18)
#define LAS __attribute__((address_space(3)))

__device__ __forceinline__ unsigned xb_ld(unsigned* p)              { return __hip_atomic_load(p, __ATOMIC_RELAXED, __HIP_MEMORY_SCOPE_AGENT); }
__device__ __forceinline__ unsigned xb_add(unsigned* p, unsigned v) { return __hip_atomic_fetch_add(p, v, __ATOMIC_RELAXED, __HIP_MEMORY_SCOPE_AGENT); }
__device__ __forceinline__ unsigned xb_xcc_id() { return (unsigned)__builtin_amdgcn_s_getreg((3 << 11) | 20) & 0xFu; }
#define XB_SPIN(cond, bar) do { unsigned _sp = 0; while (cond) { __builtin_amdgcn_s_sleep(1); \
    if ((++_sp & 255u) == 0u) { if (xb_ld(&(bar)[XB_TMO])) break; if (_sp > XB_SPIN_CAP) { atomicAdd(&(bar)[XB_TMO], 1u); break; } } } } while (0)

struct XcdBarrier {
    unsigned* bar; unsigned x;
    volatile LAS unsigned* st;
};

__device__ __forceinline__ XcdBarrier xcd_barrier_post(unsigned* bar, volatile LAS unsigned* st) {
    XcdBarrier b; b.bar = bar; b.x = xb_xcc_id(); b.st = st;
    if (threadIdx.x == 0) (void)xb_add(&bar[XB_XCNT(b.x)], 1u);
    return b;
}
__device__ __forceinline__ void xcd_barrier_complete(unsigned* bar, unsigned x, unsigned& nloc, unsigned& nx) {
    const unsigned G = gridDim.x * gridDim.y * gridDim.z;
    unsigned sum, cnt, mine, sp = 0u;
    for (;;) {
        sum = 0u; cnt = 0u; mine = 0u;
#pragma unroll
        for (unsigned j = 0; j < 16; ++j) { const unsigned c = xb_ld(&bar[XB_XCNT(j)]); sum += c; cnt += (c > 0u) ? 1u : 0u; mine = (j == x) ? c : mine; }
        if (sum == G) break;
        __builtin_amdgcn_s_sleep(1);
        if ((++sp & 255u) == 0u) { if (xb_ld(&bar[XB_TMO])) break; if (sp > XB_SPIN_CAP) { atomicAdd(&bar[XB_TMO], 1u); break; } }
    }
    nloc = mine > 0u ? mine : 1u; nx = cnt > 0u ? cnt : 1u;
}

__device__ __forceinline__ void xcd_barrier(const XcdBarrier& b) {
    asm volatile("s_waitcnt vmcnt(0)" ::: "memory");
    __syncthreads();
    if (threadIdx.x == 0) {
        unsigned* bar = b.bar;
        __builtin_amdgcn_s_waitcnt(0);
        unsigned nloc = b.st[0], nx = b.st[1];
        if (nloc == 0u) { xcd_barrier_complete(bar, b.x, nloc, nx); b.st[0] = nloc; b.st[1] = nx; }
        const unsigned old = xb_add(&bar[XB_XSUB(b.x)], 1u);
        const unsigned gen = old / nloc;
        if (old + 1u == (gen + 1u) * nloc) {
            __builtin_amdgcn_fence(__ATOMIC_RELEASE, "agent");
            asm volatile("s_waitcnt vmcnt(0)" ::: "memory");
            const unsigned og = xb_add(&bar[XB_TOP], 1u);
            const unsigned tg = og / nx;
            if (og + 1u == (tg + 1u) * nx) xb_add(&bar[XB_TOPGEN], 1u);
            else XB_SPIN(xb_ld(&bar[XB_TOPGEN]) == tg, bar);
            __builtin_amdgcn_fence(__ATOMIC_ACQUIRE, "agent");
            xb_add(&bar[XB_XGEN(b.x)], 1u);
            asm volatile("s_waitcnt vmcnt(0)" ::: "memory");
        } else {
            XB_SPIN(xb_ld(&bar[XB_XGEN(b.x)]) == gen, bar);
            __builtin_amdgcn_fence(__ATOMIC_ACQUIRE, "agent");
            asm volatile("s_waitcnt vmcnt(0)" ::: "memory");
        }
    }
    __syncthreads();
}

namespace pg8 {
#define PG8_LAS __attribute__((address_space(3)))
typedef unsigned short bf16_t;
typedef short bf16x8 __attribute__((ext_vector_type(8)));
typedef float f32x4 __attribute__((ext_vector_type(4)));
typedef unsigned u32x4 __attribute__((ext_vector_type(4)));
constexpr int BM = 256, BK = 64, HALF = 128, HTB = HALF * BK * 2  , STAGE_BYTES = 8 * HTB, NXCD = 8, WGM = 8;

__host__ __device__ __forceinline__ int lds_byte(int r, int c) { const int st = (r >> 4) * 2 + (c >> 5), rr = r & 15, cc = c & 31, ob = rr * 64 + cc * 2; return st * 1024 + (ob ^ (((ob >> 9) & 1) << 5)); }
__host__ __device__ __forceinline__ void stage_rc(int b, int& R, int& C) { const int st = b / 1024, sb = b % 1024, swz = sb ^ (((sb >> 9) & 1) << 5); R = (st >> 1) * 16 + swz / 64; C = (st & 1) * 32 + (swz % 64) / 2; }
__host__ __device__ __forceinline__ int perm32(int rho) { const int n = rho >> 4, i = rho & 15; return 8 * (i >> 2) + 4 * n + (i & 3); }

struct Unit { int pm, pn; };
struct Gemm { const bf16_t* A; const bf16_t* Bt; int M, N, K; };

struct StaticOrder {
    int nM, nN, nwg, G, c;
    __host__ __device__ void init(int M, int N, int G_, int c_) { nM = M / BM; nN = N / BM; nwg = nM * nN; G = G_; c = c_; }
    __host__ __device__ bool next(int i, Unit& u) const {
        const long L = (long)i * G + c; if (L >= nwg) return false;
        int wgid = (int)L; { const int q = nwg / NXCD, r = nwg % NXCD, xcd = wgid % NXCD, off = wgid / NXCD; wgid = (xcd < r ? xcd * (q + 1) : r * (q + 1) + (xcd - r) * q) + off; }
        const int nig = WGM * nN, gid = wgid / nig, fm = gid * WGM, gsz = (nM - fm) < WGM ? (nM - fm) : WGM;
        u.pm = fm + ((wgid % nig) % gsz); u.pn = (wgid % nig) / gsz; return true;
    }
    __device__ __forceinline__ void a_ready(const Unit&) const {}
    __device__ __forceinline__ void done(const Unit&) const {}
};
struct CountedOrder : StaticOrder {
    const unsigned* ready; unsigned need; unsigned* tmo;
    __device__ __forceinline__ void a_ready(const Unit& u) const {
        if (threadIdx.x < 64) {
            const unsigned long long t0 = __builtin_amdgcn_s_memrealtime(); unsigned polls = 0;
            while ((unsigned)__builtin_amdgcn_readfirstlane(__hip_atomic_load(ready + 64 * u.pm, __ATOMIC_RELAXED, __HIP_MEMORY_SCOPE_AGENT)) < need) {
                if ((++polls & 255u) == 0u && __builtin_amdgcn_readfirstlane(__hip_atomic_load(tmo, __ATOMIC_RELAXED, __HIP_MEMORY_SCOPE_AGENT)) != 0u) break;
                if (__builtin_amdgcn_s_memrealtime() - t0 > 2000000ull) {
                    if (threadIdx.x == 0) { unsigned expect = 0u; __hip_atomic_compare_exchange_strong(tmo + 1, &expect, 0x600u | (unsigned)(u.pm & 0xff), __ATOMIC_RELAXED, __ATOMIC_RELAXED, __HIP_MEMORY_SCOPE_AGENT); __hip_atomic_store(tmo, 1u, __ATOMIC_RELAXED, __HIP_MEMORY_SCOPE_AGENT); }
                    break; }
                __builtin_amdgcn_s_sleep(2); }
            __builtin_amdgcn_fence(__ATOMIC_ACQUIRE, "agent");
            asm volatile("s_waitcnt vmcnt(0)" ::: "memory");
        }
#if !defined(BROKEN_HOOK_NO_BARRIER)
        asm volatile("" ::: "memory"); __builtin_amdgcn_s_barrier(); asm volatile("" ::: "memory");
#endif
    }
};

__device__ __forceinline__ unsigned cvt_pk_bf16(float lo, float hi) { unsigned r; asm volatile("v_cvt_pk_bf16_f32 %0, %1, %2" : "=v"(r) : "v"(lo), "v"(hi)); return r; }
typedef float f32x2 __attribute__((ext_vector_type(2)));
__device__ __forceinline__ f32x2 gelu_pk(f32x2 v) {
    const f32x2 av = __builtin_elementwise_abs(v), d = av * 0.2316418882f + 1.0f;
    f32x2 t; t.x = __builtin_amdgcn_rcpf(d.x); t.y = __builtin_amdgcn_rcpf(d.y);
    f32x2 q = t * 0.5307027145f + (-0.7265760135f); q = q * t + 0.7107068705f; q = q * t + (-0.142248368f); q = q * t + 0.127414796f; q = q * t;
    const f32x2 s = (v * v) * (-0.72134752044f);
    f32x2 e; e.x = __builtin_amdgcn_exp2f(s.x); e.y = __builtin_amdgcn_exp2f(s.y);
    const f32x2 m = v * (q * e), r = v - m;
    f32x2 o; o.x = v.x < 0.f ? m.x : r.x; o.y = v.y < 0.f ? m.y : r.y; return o;
}

struct EpiF32 {
    static constexpr bool PERM = false, AFTER_DRAIN = false;
    float* C; int ldc; const float* bias;
    __device__ __forceinline__ void operator()(const f32x4 (&acc)[2][2][4][2], const Unit& u, int wr, int wc, int fr, int fq) const {
        const int row0 = u.pm * BM + wr * 64 + fr, col0 = u.pn * BM + wc * 32 + 4 * fq;
        f32x4 bv[2][2];
#pragma unroll
        for (int bj = 0; bj < 2; ++bj)
#pragma unroll
            for (int n = 0; n < 2; ++n) bv[bj][n] = bias ? *(const f32x4*)(bias + col0 + bj * HALF + n * 16) : (f32x4){0.f, 0.f, 0.f, 0.f};
#pragma unroll
        for (int ai = 0; ai < 2; ++ai)
#pragma unroll
            for (int m = 0; m < 4; ++m) { float* rowp = C + (size_t)(row0 + ai * HALF + m * 16) * ldc + col0;
#pragma unroll
                for (int bj = 0; bj < 2; ++bj)
#pragma unroll
                    for (int n = 0; n < 2; ++n) *(f32x4*)(rowp + bj * HALF + n * 16) = acc[ai][bj][m][n] + bv[bj][n]; }
    }
};
template <int ACT  > struct EpiBf16 {
    static constexpr bool PERM = true, AFTER_DRAIN = false;
    bf16_t* O; int ldc; const float* bias; int split_cols; size_t split_stride;
    __device__ __forceinline__ void operator()(const f32x4 (&acc)[2][2][4][2], const Unit& u, int wr, int wc, int fr, int fq) const {
        const int row0 = u.pm * BM + wr * 64 + fr; int colt = u.pn * BM; bf16_t* base = O;
        if (split_cols) { const int t = colt / split_cols; base += (size_t)t * split_stride; colt -= t * split_cols; }
        const int col0 = colt + wc * 32 + 8 * fq, bcol0 = u.pn * BM + wc * 32 + 8 * fq;
        f32x4 bv[2][2];
#pragma unroll
        for (int bj = 0; bj < 2; ++bj)
#pragma unroll
            for (int n = 0; n < 2; ++n) bv[bj][n] = bias ? *(const f32x4*)(bias + bcol0 + bj * HALF + 4 * n) : (f32x4){0.f, 0.f, 0.f, 0.f};
#pragma unroll
        for (int ai = 0; ai < 2; ++ai)
#pragma unroll
            for (int m = 0; m < 4; ++m) { bf16_t* rowp = base + (size_t)(row0 + ai * HALF + m * 16) * ldc + col0;
#pragma unroll
                for (int bj = 0; bj < 2; ++bj) { f32x4 v0 = acc[ai][bj][m][0] + bv[bj][0], v1 = acc[ai][bj][m][1] + bv[bj][1];
                    if (ACT == 1) { f32x2 a = gelu_pk((f32x2){v0[0], v0[1]}), b = gelu_pk((f32x2){v0[2], v0[3]}), c = gelu_pk((f32x2){v1[0], v1[1]}), d = gelu_pk((f32x2){v1[2], v1[3]});
                        v0 = (f32x4){a.x, a.y, b.x, b.y}; v1 = (f32x4){c.x, c.y, d.x, d.y}; }
                    if (ACT == 2) {
#pragma unroll
                        for (int j = 0; j < 4; ++j) { v0[j] = 0.5f * v0[j] * (1.0f + erff(v0[j] * 0.70710678f)); v1[j] = 0.5f * v1[j] * (1.0f + erff(v1[j] * 0.70710678f)); } }
                    u32x4 w; w.x = cvt_pk_bf16(v0[0], v0[1]); w.y = cvt_pk_bf16(v0[2], v0[3]); w.z = cvt_pk_bf16(v1[0], v1[1]); w.w = cvt_pk_bf16(v1[2], v1[3]);
                    *(u32x4*)(rowp + bj * HALF) = w; } }
    }
};
template <class Epi, class Sched, bool STAMP = false>
__device__ __forceinline__ void gemm_phase(PG8_LAS unsigned char* lds, const Gemm g, const Sched& S, const Epi& E, unsigned long long* stamps) {
    const int tid = threadIdx.x, wid = __builtin_amdgcn_readfirstlane(tid >> 6), lane = tid & 63, wr = wid >> 2, wc = wid & 3, fr = lane & 15, fq = lane >> 4;
    const int K = g.K, nt = K / BK;
    int ts_lo = 0, ts_hi = 0, nts = 0; const unsigned long long rt_entry = STAMP ? (unsigned long long)wall_clock64() : 0ull;
#define PG8_STAMP() do { if (STAMP && wid == 0 && nts < 64) { const unsigned long long _c = (unsigned long long)clock64(); \
        ts_lo = (lane == nts) ? (int)(unsigned)_c : ts_lo; ts_hi = (lane == nts) ? (int)(unsigned)(_c >> 32) : ts_hi; ++nts; } } while (0)
    PG8_STAMP();
    unsigned voffA[2], voffB[2];
#pragma unroll
    for (int i = 0; i < 2; ++i) { int R, C; stage_rc(tid * 16 + i * 8192, R, C); const int Rb = Epi::PERM ? ((R & ~31) + perm32(R & 31)) : R;
        voffA[i] = (unsigned)(R * K + C) * 2u; voffB[i] = (unsigned)(Rb * K + C) * 2u; }
    const size_t kstep = (size_t)(BK * 2);
    const size_t hstep = (size_t)HALF * K * 2;
    const size_t tstep = 2 * hstep;
    const unsigned ldsw = (unsigned)wid * 1024u;
    const int aoff = lds_byte(wr * 64 + fr, fq * 8), boff = lds_byte(wc * 32 + fr, fq * 8);
#define PG8_SA(b, h) (((b) * 2 + (h)) * HTB)
#define PG8_SB(b, h) ((4 + (b) * 2 + (h)) * HTB)
#define PG8_STAGE(bufoff, gbase, voff) do { _Pragma("unroll") for (int _i = 0; _i < 2; ++_i) \
        __builtin_amdgcn_global_load_lds((const unsigned*)((const char*)(gbase) + (voff)[_i]), (PG8_LAS unsigned*)(lds + (bufoff) + ldsw + _i * 8192), 16, 0, 0); } while (0)
#define PG8_LDA(dst, b, h) do { _Pragma("unroll") for (int m = 0; m < 4; ++m) _Pragma("unroll") for (int k = 0; k < 2; ++k) dst[m][k] = *(const PG8_LAS bf16x8*)(lds + PG8_SA(b, h) + aoff + m * 2048 + k * 1024); } while (0)
#define PG8_LDB(dst, b, h) do { _Pragma("unroll") for (int n = 0; n < 2; ++n) _Pragma("unroll") for (int k = 0; k < 2; ++k) dst[n][k] = *(const PG8_LAS bf16x8*)(lds + PG8_SB(b, h) + boff + n * 2048 + k * 1024); } while (0)
#define PG8_MMA(ai, bj, At, Bt) do { __builtin_amdgcn_s_setprio(1); _Pragma("unroll") for (int m = 0; m < 4; ++m) _Pragma("unroll") for (int n = 0; n < 2; ++n) _Pragma("unroll") for (int k = 0; k < 2; ++k) \
        acc[ai][bj][m][n] = __builtin_amdgcn_mfma_f32_16x16x32_bf16(Bt[n][k], At[m][k], acc[ai][bj][m][n], 0, 0, 0); __builtin_amdgcn_s_setprio(0); } while (0)
#define PG8_WAIT_V(n) asm volatile("s_waitcnt vmcnt(" #n ")" ::: "memory")
#define PG8_WAIT_L(n) asm volatile("s_waitcnt lgkmcnt(" #n ")" ::: "memory")
#define PG8_BAR __builtin_amdgcn_s_barrier()
#define PG8_SCHED __builtin_amdgcn_sched_barrier(0)
    Unit cur, nxt; int ui = 0;
    if (!S.next(0, cur)) return;
    f32x4 acc[2][2][4][2];
#pragma unroll
    for (int a = 0; a < 2; ++a)
#pragma unroll
        for (int b = 0; b < 2; ++b)
#pragma unroll
            for (int m = 0; m < 4; ++m)
#pragma unroll
                for (int n = 0; n < 2; ++n) acc[a][b][m][n] = (f32x4){0.f, 0.f, 0.f, 0.f};
    bf16x8 At[4][2], B0[2][2], B1[2][2];
    const char* cA = (const char*)g.A + (size_t)cur.pm * tstep; const char* cB = (const char*)g.Bt + (size_t)cur.pn * tstep;
    S.a_ready(cur);
    PG8_STAGE(PG8_SB(0, 0), cB, voffB); PG8_STAGE(PG8_SA(0, 0), cA, voffA); PG8_STAGE(PG8_SB(0, 1), cB + hstep, voffB); PG8_STAGE(PG8_SA(0, 1), cA + hstep, voffA);
    if (wr == 1) PG8_BAR;
    PG8_WAIT_V(4); PG8_BAR;
    PG8_STAGE(PG8_SB(1, 0), cB + kstep, voffB); PG8_STAGE(PG8_SA(1, 0), cA + kstep, voffA); PG8_STAGE(PG8_SB(1, 1), cB + hstep + kstep, voffB);
    PG8_WAIT_V(6); PG8_BAR;
    PG8_STAMP();
    for (;;) {
        const bool has_next = S.next(ui + 1, nxt);
        const char* nA = has_next ? (const char*)g.A + (size_t)nxt.pm * tstep : cA; const char* nB = has_next ? (const char*)g.Bt + (size_t)nxt.pn * tstep : cB;
        for (int t = 0; t < nt; t += 2) {
            const bool last = (t == nt - 2);
            const char* a1 = cA + (size_t)(t + 1) * kstep;
            const char* a2 = last ? nA : cA + (size_t)(t + 2) * kstep; const char* b2 = last ? nB : cB + (size_t)(t + 2) * kstep;
            const char* a3 = a2 + kstep; const char* b3 = b2 + kstep;
            if (last && has_next) S.a_ready(nxt);
            PG8_LDB(B0, 0, 0); PG8_SCHED; PG8_LDA(At, 0, 0); PG8_STAGE(PG8_SA(1, 1), a1 + hstep, voffA);
            PG8_WAIT_L(8); PG8_BAR; PG8_WAIT_L(0); PG8_MMA(0, 0, At, B0); PG8_BAR; PG8_SCHED;
            PG8_LDB(B1, 0, 1); PG8_STAGE(PG8_SB(0, 0), b2, voffB);
            PG8_BAR; PG8_WAIT_L(0); PG8_MMA(0, 1, At, B1); PG8_BAR;
            PG8_LDA(At, 0, 1); PG8_STAGE(PG8_SA(0, 0), a2, voffA);
            PG8_BAR; PG8_WAIT_L(0); PG8_MMA(1, 0, At, B0); PG8_BAR; PG8_SCHED;
            PG8_STAGE(PG8_SB(0, 1), b2 + hstep, voffB);
            PG8_WAIT_V(6); PG8_BAR; PG8_MMA(1, 1, At, B1); PG8_BAR;
            PG8_LDB(B0, 1, 0); PG8_SCHED; PG8_LDA(At, 1, 0); PG8_STAGE(PG8_SA(0, 1), a2 + hstep, voffA);
            PG8_WAIT_L(8); PG8_BAR; PG8_WAIT_L(0); PG8_MMA(0, 0, At, B0); PG8_BAR; PG8_SCHED;
            PG8_LDB(B1, 1, 1); PG8_STAGE(PG8_SB(1, 0), b3, voffB);
            PG8_BAR; PG8_WAIT_L(0); PG8_MMA(0, 1, At, B1); PG8_BAR;
            PG8_LDA(At, 1, 1); PG8_STAGE(PG8_SA(1, 0), a3, voffA);
            PG8_BAR; PG8_WAIT_L(0); PG8_MMA(1, 0, At, B0); PG8_BAR; PG8_SCHED;
            PG8_STAGE(PG8_SB(1, 1), b3 + hstep, voffB);
            PG8_WAIT_V(6); PG8_BAR; PG8_MMA(1, 1, At, B1); PG8_BAR;
        }
        PG8_STAMP();
        if constexpr (!Epi::AFTER_DRAIN) { E(acc, cur, wr, wc, fr, fq); S.done(cur); }
        PG8_STAMP();
        if (!has_next) break;
#pragma unroll
        for (int a = 0; a < 2; ++a)
#pragma unroll
            for (int b = 0; b < 2; ++b)
#pragma unroll
                for (int m = 0; m < 4; ++m)
#pragma unroll
                    for (int n = 0; n < 2; ++n) acc[a][b][m][n] = (f32x4){0.f, 0.f, 0.f, 0.f};
        cur = nxt; cA = nA; cB = nB; ++ui;
    }
    PG8_WAIT_V(0);
    if (wr == 0) PG8_BAR;
    PG8_BAR;
    if constexpr (Epi::AFTER_DRAIN) { E.fused(acc, cur, wr, wc, fr, fq, lds, wid, lane); S.done(cur); }
    PG8_STAMP();
    if (STAMP && wid == 0) { stamps[lane] = lane < nts ? (((unsigned long long)(unsigned)ts_hi << 32) | (unsigned)ts_lo) : 0ull;
        if (lane == 62) stamps[62] = rt_entry; if (lane == 63) stamps[63] = (unsigned long long)wall_clock64(); }
#undef PG8_STAMP
#undef PG8_SA
#undef PG8_SB
#undef PG8_STAGE
#undef PG8_LDA
#undef PG8_LDB
#undef PG8_MMA
#undef PG8_WAIT_V
#undef PG8_WAIT_L
#undef PG8_BAR
#undef PG8_SCHED
}
}

using pg8::bf16x8; using pg8::f32x4;

__device__ void phase_prep(const Params& p, unsigned char* smem) {
    const int tid = threadIdx.x, lane = tid & 63, wave = tid >> 6;
    u16* winT = (u16*)(p.ws + OFF_WINT); u16* woutT = (u16*)(p.ws + OFF_WOUTT); u16* wqT = (u16*)(p.ws + OFF_WQT);
    float* tile = (float*)smem;
    for (int tg4 = blockIdx.x; tg4 < 1408; tg4 += gridDim.x) {
        float4 v[4][2];
#pragma unroll
        for (int q = 0; q < 4; ++q) {
            const int tl = tg4 * 4 + q;
            const float* src; int ld, kt, nt;
            if (tl < 3584) { src = p.w_in; ld = DIN; kt = tl / 112; nt = tl % 112; }
            else if (tl < 4608) { const int r = tl - 3584; src = p.w_out; ld = DM; kt = r >> 5; nt = r & 31; }
            else { const int r = tl - 4608; src = p.wq; ld = DM; kt = r >> 5; nt = r & 31; }
#pragma unroll
            for (int i = 0; i < 2; ++i) { const int id = tid + i * 512, r = id >> 4, c4 = (id & 15) * 4; v[q][i] = *(const float4*)(src + (size_t)(kt * 64 + r) * ld + nt * 64 + c4); }
        }
#pragma unroll
        for (int q = 0; q < 4; ++q)
#pragma unroll
            for (int i = 0; i < 2; ++i) {
                const int id = tid + i * 512, r = id >> 4, c4 = (id & 15) * 4; float* tq = tile + q * 4160;
                tq[r * 65 + c4 + 0] = v[q][i].x; tq[r * 65 + c4 + 1] = v[q][i].y; tq[r * 65 + c4 + 2] = v[q][i].z; tq[r * 65 + c4 + 3] = v[q][i].w;
            }
        __syncthreads();
#pragma unroll
        for (int q = 0; q < 4; ++q) {
            const int tl = tg4 * 4 + q;
            u16* dst; int kt, nt;
            if (tl < 3584) { dst = winT; kt = tl / 112; nt = tl % 112; }
            else if (tl < 4608) { const int r = tl - 3584; dst = woutT; kt = r >> 5; nt = r & 31; }
            else { const int r = tl - 4608; dst = wqT; kt = r >> 5; nt = r & 31; }
            const int n = tid >> 3, k8 = (tid & 7) * 8; float f[8]; const float* tq = tile + q * 4160;
#pragma unroll
            for (int j = 0; j < 8; ++j) f[j] = tq[(k8 + j) * 65 + n];
            uint4 w; w.x = pk2(f[0], f[1]); w.y = pk2(f[2], f[3]); w.z = pk2(f[4], f[5]); w.w = pk2(f[6], f[7]);
            *(uint4*)(dst + (size_t)(nt * 64 + n) * 2048 + kt * 64 + k8) = w;
        }
        __syncthreads();
    }
    {
        u16* keyb = (u16*)(p.ws + OFF_KEYB);
        for (int i = blockIdx.x * 512 + tid; i < 65536; i += gridDim.x * 512) {
            const float4 v = *(const float4*)(p.keys + (size_t)i * 4);
            uint2 w; w.x = pk2(v.x, v.y); w.y = pk2(v.z, v.w); *(uint2*)(keyb + (size_t)i * 4) = w;
        }
    }
    float* Wg = (float*)smem;
    for (int idx = tid; idx < 32768; idx += 512) { const int k = idx >> 4, g = idx & 15; Wg[g * 2048 + k] = p.w_in[(size_t)k * DIN + NPJ + g]; }
    __syncthreads();
    u16* h0b = (u16*)(p.ws + OFF_H0B); float* gates = (float*)(p.ws + OFF_GATES);
    unsigned char* ub = p.ws + OFF_UBF; unsigned char* vb = p.ws + OFF_VBF; float* usc = (float*)(p.ws + OFF_USC); float* vsc = (float*)(p.ws + OFF_VSC);
    const int G8 = gridDim.x * 8;
    for (int t0 = blockIdx.x * 8 + wave; t0 < T_TOK; t0 += 2 * G8) {
        const int t1 = t0 + G8; const bool has1 = t1 < T_TOK; const int t1c = has1 ? t1 : t0;
        float4 xv[2][8], fr[1][2][4];
#pragma unroll
        for (int i = 0; i < 8; ++i) { xv[0][i] = *(const float4*)(p.x + (size_t)t0 * DM + i * 256 + lane * 4); xv[1][i] = *(const float4*)(p.x + (size_t)t1c * DM + i * 256 + lane * 4); }
#pragma unroll
        for (int u = 0; u < 2; ++u) {
            float s = 0.f;
#pragma unroll
            for (int i = 0; i < 8; ++i) s += (xv[u][i].x + xv[u][i].y) + (xv[u][i].z + xv[u][i].w);
            const float mean = wsum(s) * (1.0f / 2048.0f);
            float q = 0.f;
#pragma unroll
            for (int i = 0; i < 8; ++i) { xv[u][i].x -= mean; xv[u][i].y -= mean; xv[u][i].z -= mean; xv[u][i].w -= mean; q += xv[u][i].x * xv[u][i].x + xv[u][i].y * xv[u][i].y + xv[u][i].z * xv[u][i].z + xv[u][i].w * xv[u][i].w; }
            const float rstd = rsqrtf(wsum(q) * (1.0f / 2048.0f) + LN_EPS_F);
            const int tok = u ? t1c : t0;
#pragma unroll
            for (int i = 0; i < 8; ++i) {
                const float4 g4 = *(const float4*)(p.ln_in_g + i * 256 + lane * 4), b4 = *(const float4*)(p.ln_in_b + i * 256 + lane * 4);
                xv[u][i].x = xv[u][i].x * rstd * g4.x + b4.x; xv[u][i].y = xv[u][i].y * rstd * g4.y + b4.y; xv[u][i].z = xv[u][i].z * rstd * g4.z + b4.z; xv[u][i].w = xv[u][i].w * rstd * g4.w + b4.w;
                uint2 w; w.x = pk2(xv[u][i].x, xv[u][i].y); w.y = pk2(xv[u][i].z, xv[u][i].w);
                if (u == 0 || has1) *(uint2*)(h0b + (size_t)tok * DM + i * 256 + lane * 4) = w;
            }
        }
        {
            const float* src = ((t0 >= 16384) ? p.pv : p.pu) + (size_t)(t0 & 16383) * DM;
#pragma unroll
            for (int i = 0; i < 2; ++i)
#pragma unroll
                for (int m = 0; m < 4; ++m) fr[0][i][m] = *(const float4*)(src + i * 1024 + lane * 16 + m * 4);
        }
        float pa[16], pb[16];
#pragma unroll
        for (int g = 0; g < 16; ++g) {
            float a = 0.f, b = 0.f;
#pragma unroll
            for (int i = 0; i < 8; ++i) {
                const float4 w4 = *(const float4*)(Wg + g * 2048 + i * 256 + lane * 4);
                a += xv[0][i].x * w4.x + xv[0][i].y * w4.y + xv[0][i].z * w4.z + xv[0][i].w * w4.w;
                b += xv[1][i].x * w4.x + xv[1][i].y * w4.y + xv[1][i].z * w4.z + xv[1][i].w * w4.w;
            }
            pa[g] = a; pb[g] = b;
        }
#pragma unroll
        for (int st = 0; st < 4; ++st) {
            const int sft = 32 >> st, n2 = 8 >> st; const bool up = (lane & sft) != 0;
#pragma unroll
            for (int i = 0; i < n2; ++i) {
                const float a0 = pa[i], a1 = pa[i + n2], b0 = pb[i], b1 = pb[i + n2];
                pa[i] = (up ? a1 : a0) + __shfl_xor(up ? a0 : a1, sft);
                pb[i] = (up ? b1 : b0) + __shfl_xor(up ? b0 : b1, sft);
            }
        }
        float va = pa[0], vb2 = pb[0];
        va += __shfl_xor(va, 2); va += __shfl_xor(va, 1); vb2 += __shfl_xor(vb2, 2); vb2 += __shfl_xor(vb2, 1);
        if ((lane & 3) == 0) {
            const int g = ((lane >> 5) & 1) * 8 + ((lane >> 4) & 1) * 4 + ((lane >> 3) & 1) * 2 + ((lane >> 2) & 1);
            const float bg = p.b_gate[g];
            float z0 = va + bg, z1 = vb2 + bg;
            if (g >= 8) { z0 = fminf(z0, 0.f) - log1pf(__expf(-fabsf(z0))); z1 = fminf(z1, 0.f) - log1pf(__expf(-fabsf(z1))); }
            gates[(size_t)t0 * 16 + g] = z0;
            if (has1) gates[(size_t)t1 * 16 + g] = z1;
        }
#pragma unroll
        for (int u = 0; u < 2; ++u) {
            if (u == 1 && !has1) break;
            const int row = u ? t1 : t0; const int r = row & 16383; const bool isv = row >= 16384;
            if (u == 1) {
                const float* src = (isv ? p.pv : p.pu) + (size_t)r * DM;
#pragma unroll
                for (int i = 0; i < 2; ++i)
#pragma unroll
                    for (int m = 0; m < 4; ++m) fr[0][i][m] = *(const float4*)(src + i * 1024 + lane * 16 + m * 4);
            }
            float am = 0.f;
#pragma unroll
            for (int i = 0; i < 2; ++i)
#pragma unroll
                for (int m = 0; m < 4; ++m) am = fmaxf(am, fmaxf(fmaxf(fabsf(fr[0][i][m].x), fabsf(fr[0][i][m].y)), fmaxf(fabsf(fr[0][i][m].z), fabsf(fr[0][i][m].w))));
            am = wmaxf(am);
            int ex = 0; if (am > 0.f) (void)frexpf(am, &ex); else ex = 8;
            const float sc = isv ? ldexpf(1.0f, 8 - ex) : (am > 0.f ? 127.0f / am : 0.f), isc = isv ? ldexpf(1.0f, ex - 8) : am * (1.0f / 127.0f);
#pragma unroll
            for (int i = 0; i < 2; ++i) {
                unsigned w[4];
#pragma unroll
                for (int m = 0; m < 4; ++m) {
                    if (isv) { int t = 0; t = __builtin_amdgcn_cvt_pk_fp8_f32(fr[0][i][m].x * sc, fr[0][i][m].y * sc, t, false); t = __builtin_amdgcn_cvt_pk_fp8_f32(fr[0][i][m].z * sc, fr[0][i][m].w * sc, t, true); w[m] = (unsigned)t; }
                    else { const int q0 = (int)rintf(fr[0][i][m].x * sc), q1 = (int)rintf(fr[0][i][m].y * sc), q2 = (int)rintf(fr[0][i][m].z * sc), q3 = (int)rintf(fr[0][i][m].w * sc);
                        w[m] = (unsigned)(q0 & 255) | ((unsigned)(q1 & 255) << 8) | ((unsigned)(q2 & 255) << 16) | ((unsigned)(q3 & 255) << 24); }
                }
                *(uint4*)((isv ? vb : ub) + (size_t)(i * 8 + (lane >> 3)) * SLICE_BYTES + (size_t)r * 128 + (lane & 7) * 16) = make_uint4(w[0], w[1], w[2], w[3]);
            }
            if (lane == 0) (isv ? vsc : usc)[r] = isc;
        }
    }
}

__device__ void phase_conv_local(const Params& p, unsigned char* smem) {
    const int tid = threadIdx.x, lane = tid & 63, wave = tid >> 6;
    const u16* proj = (const u16*)(p.ws + OFF_PROJ); u16* ymix = (u16*)(p.ws + OFF_YMIX);
#if PROBE_DUP == 20
    for (int prep_ = 0; prep_ < 2; ++prep_)
#endif
    for (int task = blockIdx.x * 512 + tid; task < 131072; task += gridDim.x * 512) {
        const int cgp = task & 127, run = task >> 7, t0 = run * 32, c0 = cgp * 8;
        float w0[8], w1[8], w2[8], bb[8], z1[8], z2[8];
#pragma unroll
        for (int j = 0; j < 8; ++j) { w0[j] = p.conv_w[c0 + j]; w1[j] = p.conv_w[1024 + c0 + j]; w2[j] = p.conv_w[2048 + c0 + j]; bb[j] = p.conv_b[c0 + j]; z1[j] = 0.f; z2[j] = 0.f; }
        if ((t0 & (SEQ_L - 1)) != 0) {
            float a[8], b[8];
            unpack8(*(const uint4*)(proj + (size_t)(t0 - 2) * NPJ + 1024 + c0), a); unpack8(*(const uint4*)(proj + (size_t)(t0 - 2) * NPJ + 2048 + c0), b);
#pragma unroll
            for (int j = 0; j < 8; ++j) z2[j] = a[j] * b[j];
            unpack8(*(const uint4*)(proj + (size_t)(t0 - 1) * NPJ + 1024 + c0), a); unpack8(*(const uint4*)(proj + (size_t)(t0 - 1) * NPJ + 2048 + c0), b);
#pragma unroll
            for (int j = 0; j < 8; ++j) z1[j] = a[j] * b[j];
        }
#pragma unroll 1
        for (int tb = t0; tb < t0 + 32; tb += 8) {
            uint4 rb[8], rc[8], rh[8];
#pragma unroll
            for (int u = 0; u < 8; ++u) { rb[u] = *(const uint4*)(proj + (size_t)(tb + u) * NPJ + c0); rc[u] = *(const uint4*)(proj + (size_t)(tb + u) * NPJ + 1024 + c0); rh[u] = *(const uint4*)(proj + (size_t)(tb + u) * NPJ + 2048 + c0); }
#pragma unroll
            for (int u = 0; u < 8; ++u) {
                float cb[8], cc[8], ch[8], y[8];
                unpack8(rb[u], cb); unpack8(rc[u], cc); unpack8(rh[u], ch);
#pragma unroll
                for (int j = 0; j < 8; ++j) { const float z = cc[j] * ch[j]; y[j] = cb[j] * (bb[j] + w0[j] * z2[j] + w1[j] * z1[j] + w2[j] * z); z2[j] = z1[j]; z1[j] = z; }
                uint4 w; w.x = pk2(y[0], y[1]); w.y = pk2(y[2], y[3]); w.z = pk2(y[4], y[5]); w.w = pk2(y[6], y[7]);
                *(uint4*)(ymix + (size_t)(tb + u) * DM + c0) = w;
            }
        }
    }
    const float* gates = (const float*)(p.ws + OFF_GATES);
    u16* dC = (u16*)p.out; float* dn = (float*)(p.ws + OFF_DN); float* MG = (float*)(p.ws + OFF_MG); float* BL = (float*)(p.ws + OFF_BL);
    u16* KT = (u16*)smem;
    u16* VT = (u16*)(smem + 18432);
    float* wk_s = (float*)(smem + 36864);
    uint4 kv[2], vv[2]; float li = 0.f, lf = 0.f;
#if PROBE_DUP == 21
    for (int prep_ = 0; prep_ < 2; ++prep_) {
#endif
    {
        const int it0 = blockIdx.x;
        if (it0 < 4096) {
            const int bh = it0 >> 8, c = it0 & 255, b = bh >> 3, h = bh & 7, t0 = b * SEQ_L + c * 64;
#pragma unroll
            for (int i = 0; i < 2; ++i) { const int id = tid + i * 512, l = id >> 4, c8 = (id & 15) * 8;
                kv[i] = *(const uint4*)(proj + (size_t)(t0 + l) * NPJ + 4096 + h * 128 + c8); vv[i] = *(const uint4*)(proj + (size_t)(t0 + l) * NPJ + 5120 + h * 128 + c8); }
            if (wave == 0) { li = gates[(size_t)(t0 + lane) * 16 + h]; lf = gates[(size_t)(t0 + lane) * 16 + 8 + h]; }
        }
    }
    for (int it = blockIdx.x; it < 4096; it += gridDim.x) {
        const int item = it;
        if (wave == 0) {
            const float bc = wscan_add(lf, lane);
            const float bL = __shfl(bc, 63);
            const float g = bL - bc + li;
            const float mg = wmaxf(g);
            wk_s[lane] = __expf(g - mg);
            if (lane == 0) { MG[item] = mg; BL[item] = bL; }
        }
        __syncthreads();
#pragma unroll
        for (int i = 0; i < 2; ++i) {
            const int id = tid + i * 512, l = id >> 4, c8 = (id & 15) * 8;
            const float w = wk_s[l];
            const int pl = ((((l >> 3) ^ (c8 >> 3)) & 7) << 3) + (l & 7);
            float kf[8], vf[8]; unpack8(kv[i], kf); unpack8(vv[i], vf);
#pragma unroll
            for (int j = 0; j < 8; j += 2) {
                const unsigned kk = pk2(kf[j], kf[j + 1]), vw = pk2(vf[j] * w, vf[j + 1] * w);
                KT[(c8 + j) * 72 + pl] = (u16)(kk & 0xffffu); KT[(c8 + j + 1) * 72 + pl] = (u16)(kk >> 16);
                VT[(c8 + j) * 72 + pl] = (u16)(vw & 0xffffu); VT[(c8 + j + 1) * 72 + pl] = (u16)(vw >> 16);
            }
        }
        {
            const int nit = it + gridDim.x;
            if (nit < 4096) {
                const int bh = nit >> 8, c = nit & 255, b = bh >> 3, h = bh & 7, t0 = b * SEQ_L + c * 64;
#pragma unroll
                for (int i = 0; i < 2; ++i) { const int id = tid + i * 512, l = id >> 4, c8 = (id & 15) * 8;
                    kv[i] = *(const uint4*)(proj + (size_t)(t0 + l) * NPJ + 4096 + h * 128 + c8); vv[i] = *(const uint4*)(proj + (size_t)(t0 + l) * NPJ + 5120 + h * 128 + c8); }
                if (wave == 0) { li = gates[(size_t)(t0 + lane) * 16 + h]; lf = gates[(size_t)(t0 + lane) * 16 + 8 + h]; }
            }
        }
        __syncthreads();
        {
            const int fr = lane & 15, fq = lane >> 4, e0 = wave * 16;
            bf16x8 bfr[2];
#pragma unroll
            for (int kk = 0; kk < 2; ++kk) bfr[kk] = *(const bf16x8*)(VT + (e0 + fr) * 72 + (((kk * 4 + fq) ^ ((e0 + fr) >> 3)) & 7) * 8);
            u16* dst = dC + (size_t)item * 16384 + (size_t)(e0 + fr) * 128 + fq * 4;
#pragma unroll
            for (int dt = 0; dt < 8; ++dt) {
                f32x4 acc = {0.f, 0.f, 0.f, 0.f};
#pragma unroll
                for (int kk = 0; kk < 2; ++kk) {
                    const bf16x8 afr = *(const bf16x8*)(KT + (dt * 16 + fr) * 72 + (((kk * 4 + fq) ^ ((dt * 16 + fr) >> 3)) & 7) * 8);
                    acc = __builtin_amdgcn_mfma_f32_16x16x32_bf16(afr, bfr[kk], acc, 0, 0, 0);
                }
                uint2 w; w.x = pk2(acc[0] * QK_SCALE, acc[1] * QK_SCALE); w.y = pk2(acc[2] * QK_SCALE, acc[3] * QK_SCALE);
                *(uint2*)(dst + dt * 16) = w;
            }
        }
        if (tid < 128) {
            float a = 0.f;
#pragma unroll
            for (int l8 = 0; l8 < 8; ++l8) {
                float kf[8]; unpack8(*(const uint4*)(KT + tid * 72 + ((l8 ^ (tid >> 3)) & 7) * 8), kf);
#pragma unroll
                for (int j = 0; j < 8; ++j) a += kf[j] * wk_s[l8 * 8 + j];
            }
            dn[(size_t)item * 128 + tid] = a * QK_SCALE;
        }
        __syncthreads();
    }
#if PROBE_DUP == 21
    __syncthreads(); }
#endif
}

__device__ void phase_scan(const Params& p) {
    const int tid = threadIdx.x;
    unsigned* dC = (unsigned*)p.out; float* dn = (float*)(p.ws + OFF_DN);
    const float* MG = (const float*)(p.ws + OFF_MG); const float* BL = (const float*)(p.ws + OFF_BL); float* MST = (float*)(p.ws + OFF_MST);
    for (int s = blockIdx.x * 512 + tid; s < 16 * 8192; s += gridDim.x * 512) {
        const int bh = s >> 13, idx = s & 8191;
        unsigned* ptr = dC + (size_t)bh * 256 * 8192 + idx;
        const bool has_n = s < 2048; const int bhn = (s >> 7) & 15;
        float* nptr = dn + (size_t)bhn * 256 * 128 + (s & 127);
        float m = 0.f, s0 = 0.f, s1 = 0.f, mn_ = 0.f, sn = 0.f;
#pragma unroll 1
        for (int c = 0; c < 256; c += 32) {
            unsigned d[32]; float dnv[32];
#pragma unroll
            for (int j = 0; j < 32; ++j) { d[j] = ptr[(size_t)(c + j) * 8192]; dnv[j] = has_n ? nptr[(size_t)(c + j) * 128] : 0.f; }
#pragma unroll
            for (int j = 0; j < 32; ++j) {
                const float mg = MG[bh * 256 + c + j], bL = BL[bh * 256 + c + j];
                const float mn = fmaxf(bL + m, mg);
                const float dec = __expf(bL + m - mn), wn = __expf(mg - mn);
                s0 = dec * s0 + wn * bflo(d[j]); s1 = dec * s1 + wn * bfhi(d[j]);
                ptr[(size_t)(c + j) * 8192] = pk2(s0, s1);
                m = mn;
                if (idx == 0) MST[bh * 256 + c + j] = mn;
                if (has_n) {
                    const float mg2 = MG[bhn * 256 + c + j], bL2 = BL[bhn * 256 + c + j];
                    const float mn2 = fmaxf(bL2 + mn_, mg2);
                    sn = __expf(bL2 + mn_ - mn2) * sn + __expf(mg2 - mn2) * dnv[j];
                    nptr[(size_t)(c + j) * 128] = sn;
                    mn_ = mn2;
                }
            }
        }
    }
}

typedef unsigned u32x4v __attribute__((ext_vector_type(4)));
typedef unsigned u32x2v __attribute__((ext_vector_type(2)));
struct MlRegs { u32x4v qv[2], kv[2], vv[2], cv[4]; u32x2v ow[4]; pg8::f32x4 gn; float li, lf, mprev, nprev; };
__device__ __forceinline__ void ml_load(const Params& p, int item, int tid, int lane, int wave, MlRegs& r) {
    const u16* proj = (const u16*)(p.ws + OFF_PROJ); const float* gates = (const float*)(p.ws + OFF_GATES);
    const u16* Cst = (const u16*)p.out; const float* nst = (const float*)(p.ws + OFF_DN); const float* MST = (const float*)(p.ws + OFF_MST);
    const int bh = item >> 8, c = item & 255, b = bh >> 3, h = bh & 7, t0 = b * SEQ_L + c * 64;
    const int fr = lane & 15, fq = lane >> 4;
#pragma unroll
    for (int i = 0; i < 2; ++i) {
        const int id = tid + i * 512, l = id >> 4, c8 = (id & 15) * 8;
        r.qv[i] = *(const u32x4v*)(proj + (size_t)(t0 + l) * NPJ + 3072 + h * 128 + c8);
        r.kv[i] = *(const u32x4v*)(proj + (size_t)(t0 + l) * NPJ + 4096 + h * 128 + c8);
        r.vv[i] = *(const u32x4v*)(proj + (size_t)(t0 + l) * NPJ + 5120 + h * 128 + c8);
    }
    {
        const int pit = (c > 0) ? item - 1 : item; const bool z = (c == 0);
        const u16* Cp = Cst + (size_t)pit * 16384;
#pragma unroll
        for (int i = 0; i < 4; ++i) { const int id = tid + i * 512, e = id >> 4, d8 = (id & 15) * 8; u32x4v v = *(const u32x4v*)(Cp + e * 128 + d8); if (z) v = (u32x4v){0u, 0u, 0u, 0u}; r.cv[i] = v; }
        float nv = nst[(size_t)pit * 128 + (tid & 127)], mv = MST[pit];
        r.nprev = z ? 0.f : nv; r.mprev = z ? 0.f : mv;
    }
#pragma unroll
    for (int lt = 0; lt < 4; ++lt) r.ow[lt] = *(const u32x2v*)(proj + (size_t)(t0 + lt * 16 + fr) * NPJ + 6144 + h * 128 + wave * 16 + fq * 4);
    r.gn = *(const pg8::f32x4*)(p.mh_g + h * 128 + wave * 16 + fq * 4);
    r.li = 0.f; r.lf = 0.f;
    if (wave == 0) { r.li = gates[(size_t)(t0 + lane) * 16 + h]; r.lf = gates[(size_t)(t0 + lane) * 16 + 8 + h]; }
}

__device__ void phase_mlstm_out(const Params& p, unsigned char* smem) {
    const int tid = threadIdx.x, lane = tid & 63, wave = tid >> 6;
    u16* ymix = (u16*)(p.ws + OFF_YMIX);
    u16* Qs = (u16*)smem;
    u16* Ks = (u16*)(smem + 17408);
    u16* VT = (u16*)(smem + 34816);
    u16* Cb = (u16*)(smem + 53248);
    u16* Ss = (u16*)(smem + 88064);
    float* fa = (float*)(smem + 97280);
    float* a_s = fa, *mm_s = fa + 64, *wi_s = fa + 128, *emt_s = fa + 192, *den_s = fa + 256, *nq_s = fa + 320, *sum_s = fa + 384, *sq_s = fa + 448, *n_s = fa + 512;
    const int fr = lane & 15, fq = lane >> 4;
    MlRegs r;
#define ML_ITEM(it_) (it_)
    if ((int)blockIdx.x < 4096) ml_load(p, ML_ITEM((int)blockIdx.x), tid, lane, wave, r);
    for (int it = blockIdx.x; it < 4096; it += gridDim.x) {
        const int item = ML_ITEM(it);
        const int bh = item >> 8, c = item & 255, b = bh >> 3, h = bh & 7;
        const int t0 = b * SEQ_L + c * 64;
        if (wave == 0) {
            const float bc = wscan_add(r.lf, lane);
            const float a = r.li - bc;
            const float pm = wscan_max(a, lane);
            const float mprev = r.mprev;
            const float mm = fmaxf(mprev, pm);
            a_s[lane] = a; mm_s[lane] = mm; wi_s[lane] = __expf(mprev - mm); emt_s[lane] = __expf(-(bc + mm));
            den_s[lane] = 0.f; sum_s[lane] = 0.f; sq_s[lane] = 0.f;
        }
#pragma unroll
        for (int i = 0; i < 2; ++i) {
            const int id = tid + i * 512, l = id >> 4, c8 = (id & 15) * 8;
            *(u32x4v*)(Qs + l * 136 + c8) = r.qv[i]; *(u32x4v*)(Ks + l * 136 + c8) = r.kv[i];
            const unsigned vw[4] = {r.vv[i].x, r.vv[i].y, r.vv[i].z, r.vv[i].w};
            const int pl = ((((l >> 3) ^ (c8 >> 3)) & 7) << 3) + (l & 7);
#pragma unroll
            for (int j = 0; j < 4; ++j) { VT[(c8 + 2 * j) * 72 + pl] = (u16)(vw[j] & 0xffffu); VT[(c8 + 2 * j + 1) * 72 + pl] = (u16)(vw[j] >> 16); }
        }
#pragma unroll
        for (int i = 0; i < 4; ++i) { const int id = tid + i * 512, e = id >> 4, d8 = (id & 15) * 8; *(u32x4v*)(Cb + e * 136 + d8) = r.cv[i]; }
        if (tid < 128) n_s[tid] = r.nprev;
        u32x2v ow[4];
#pragma unroll
        for (int lt = 0; lt < 4; ++lt) ow[lt] = r.ow[lt];
        const pg8::f32x4 gn = r.gn;
        __syncthreads();
        if (it + (int)gridDim.x < 4096) ml_load(p, ML_ITEM(it + (int)gridDim.x), tid, lane, wave, r);
        float hv[4][4];
#if PROBE_DUP == 41
        for (int prep_ = 0; prep_ < 2; ++prep_) {
        if (prep_) { __syncthreads(); if (wave == 0) { den_s[lane] = 0.f; sum_s[lane] = 0.f; sq_s[lane] = 0.f; } __syncthreads(); }
#endif
        {
            const int lt = wave >> 1, l = lt * 16 + fr; const float mml = mm_s[l];
#pragma unroll
            for (int jj = 0; jj < 2; ++jj) {
                const int jt = (wave & 1) * 2 + jj, j0 = jt * 16 + fq * 4;
                float sv[4] = {0.f, 0.f, 0.f, 0.f};
                if (jt <= lt) {
                    f32x4 acc = {0.f, 0.f, 0.f, 0.f};
#pragma unroll
                    for (int kk = 0; kk < 4; ++kk) {
                        const bf16x8 afr = *(const bf16x8*)(Ks + (jt * 16 + fr) * 136 + kk * 32 + fq * 8);
                        const bf16x8 bfr = *(const bf16x8*)(Qs + (lt * 16 + fr) * 136 + kk * 32 + fq * 8);
                        acc = __builtin_amdgcn_mfma_f32_16x16x32_bf16(afr, bfr, acc, 0, 0, 0);
                    }
#pragma unroll
                    for (int rr = 0; rr < 4; ++rr) { const int j = j0 + rr; sv[rr] = (j <= l) ? acc[rr] * QK_SCALE * __expf(a_s[j] - mml) : 0.f; }
                }
                float rs = (sv[0] + sv[1]) + (sv[2] + sv[3]);
                rs += __shfl_xor(rs, 16); rs += __shfl_xor(rs, 32);
                if (fq == 0 && jt <= lt) atomicAdd(&den_s[l], rs);
                uint2 w; w.x = pk2(sv[0], sv[1]); w.y = pk2(sv[2], sv[3]);
                *(uint2*)(Ss + l * 72 + j0) = w;
            }
        }
        {
            const int l = tid >> 3, d0 = (tid & 7) * 16; float a = 0.f;
#pragma unroll
            for (int u = 0; u < 2; ++u) {
                float qf[8]; unpack8(*(const uint4*)(Qs + l * 136 + d0 + u * 8), qf);
#pragma unroll
                for (int j = 0; j < 8; ++j) a += qf[j] * n_s[d0 + u * 8 + j];
            }
            a += __shfl_xor(a, 1); a += __shfl_xor(a, 2); a += __shfl_xor(a, 4);
            if ((tid & 7) == 0) nq_s[l] = a;
        }
        __syncthreads();
        {
            const int e0 = wave * 16;
            bf16x8 av[2], ac[4];
#pragma unroll
            for (int kk = 0; kk < 2; ++kk) av[kk] = *(const bf16x8*)(VT + (e0 + fr) * 72 + (((kk * 4 + fq) ^ ((e0 + fr) >> 3)) & 7) * 8);
#pragma unroll
            for (int kk = 0; kk < 4; ++kk) ac[kk] = *(const bf16x8*)(Cb + (e0 + fr) * 136 + kk * 32 + fq * 8);
#pragma unroll
            for (int lt = 0; lt < 4; ++lt) {
                const int l = lt * 16 + fr;
                f32x4 a1 = {0.f, 0.f, 0.f, 0.f}, a2 = {0.f, 0.f, 0.f, 0.f};
#pragma unroll
                for (int kk = 0; kk < 2; ++kk) { const bf16x8 bs = *(const bf16x8*)(Ss + l * 72 + kk * 32 + fq * 8); a1 = __builtin_amdgcn_mfma_f32_16x16x32_bf16(av[kk], bs, a1, 0, 0, 0); }
#pragma unroll
                for (int kk = 0; kk < 4; ++kk) { const bf16x8 bq = *(const bf16x8*)(Qs + l * 136 + kk * 32 + fq * 8); a2 = __builtin_amdgcn_mfma_f32_16x16x32_bf16(ac[kk], bq, a2, 0, 0, 0); }
                const float wi = wi_s[l];
                const float den = den_s[l] + wi * nq_s[l];
                const float inv = 1.0f / fmaxf(fabsf(den), emt_s[l]);
                float s1 = 0.f, s2 = 0.f;
#pragma unroll
                for (int rr = 0; rr < 4; ++rr) { const float hh = (a1[rr] + wi * a2[rr]) * inv; hv[lt][rr] = hh; s1 += hh; s2 += hh * hh; }
                s1 += __shfl_xor(s1, 16); s1 += __shfl_xor(s1, 32); s2 += __shfl_xor(s2, 16); s2 += __shfl_xor(s2, 32);
                if (fq == 0) { atomicAdd(&sum_s[l], s1); atomicAdd(&sq_s[l], s2); }
            }
        }
#if PROBE_DUP == 41
        }
#endif
        __syncthreads();
        {
            const int e = wave * 16 + fq * 4;
#pragma unroll
            for (int lt = 0; lt < 4; ++lt) {
                const int l = lt * 16 + fr;
                const float mean = sum_s[l] * (1.0f / 128.0f);
                const float var = fmaxf(sq_s[l] * (1.0f / 128.0f) - mean * mean, 0.f);
                const float rstd = rsqrtf(var + LN_EPS_F);
                const float o0 = bflo(ow[lt].x), o1 = bfhi(ow[lt].x), o2 = bflo(ow[lt].y), o3 = bfhi(ow[lt].y);
                const float y0 = (hv[lt][0] - mean) * rstd * gn[0] / (1.0f + __expf(-o0));
                const float y1 = (hv[lt][1] - mean) * rstd * gn[1] / (1.0f + __expf(-o1));
                const float y2 = (hv[lt][2] - mean) * rstd * gn[2] / (1.0f + __expf(-o2));
                const float y3 = (hv[lt][3] - mean) * rstd * gn[3] / (1.0f + __expf(-o3));
                uint2 w; w.x = pk2(y0, y1); w.y = pk2(y2, y3);
                *(uint2*)(ymix + (size_t)(t0 + l) * DM + 1024 + h * 128 + e) = w;
            }
        }
        __syncthreads();
    }
}

struct EpiPre {
    static constexpr bool PERM = false, AFTER_DRAIN = false;
    float* C; const u16* h0;
    __device__ __forceinline__ void operator()(const f32x4 (&acc)[2][2][4][2], const pg8::Unit& u, int wr, int wc, int fr, int fq) const {
        const int row0 = u.pm * 256 + wr * 64 + fr, col0 = u.pn * 256 + wc * 32 + 4 * fq;
#pragma unroll
        for (int ai = 0; ai < 2; ++ai)
#pragma unroll
            for (int m = 0; m < 4; ++m) {
                const size_t ro = (size_t)(row0 + ai * 128 + m * 16) * DM + col0;
#pragma unroll
                for (int bj = 0; bj < 2; ++bj)
#pragma unroll
                    for (int n = 0; n < 2; ++n) {
                        const uint2 hb = *(const uint2*)(h0 + ro + bj * 128 + n * 16);
                        f32x4 r = acc[ai][bj][m][n];
                        r[0] += ALPHA_F * bflo(hb.x); r[1] += ALPHA_F * bfhi(hb.x); r[2] += ALPHA_F * bflo(hb.y); r[3] += ALPHA_F * bfhi(hb.y);
                        *(f32x4*)(C + ro + bj * 128 + n * 16) = r;
                    }
            }
    }
};

__device__ void phase_ln1(const Params& p) {
    const int tid = threadIdx.x, lane = tid & 63, wave = tid >> 6;
    u16* h1b = (u16*)(p.ws + OFF_H1B); float* lns = (float*)(p.ws + OFF_LNS); unsigned char* h1f8 = p.ws + OFF_H1F8; float* xsc = (float*)(p.ws + OFF_XSC);
    const u16* h0b = (const u16*)(p.ws + OFF_H0B); const u16* mixb = (const u16*)(p.ws + OFF_MIXB);
    float4 lg[8], lb[8];
#pragma unroll
    for (int i = 0; i < 8; ++i) { lg[i] = *(const float4*)(p.ln1_g + i * 256 + lane * 4); lb[i] = *(const float4*)(p.ln1_b + i * 256 + lane * 4); }
    uint2 hn[8], mn[8];
    {
        const int tok = blockIdx.x * 8 + wave;
        if (tok < T_TOK) {
#pragma unroll
            for (int i = 0; i < 8; ++i) { hn[i] = *(const uint2*)(h0b + (size_t)tok * DM + i * 256 + lane * 4); mn[i] = *(const uint2*)(mixb + (size_t)tok * DM + i * 256 + lane * 4); } }
    }
    for (int tok = blockIdx.x * 8 + wave; tok < T_TOK; tok += gridDim.x * 8) {
        float4 xv[8];
#pragma unroll
        for (int i = 0; i < 8; ++i) {
            const uint2 hw = hn[i], mw = mn[i];
            xv[i].x = ALPHA_F * bflo(hw.x) + bflo(mw.x); xv[i].y = ALPHA_F * bfhi(hw.x) + bfhi(mw.x); xv[i].z = ALPHA_F * bflo(hw.y) + bflo(mw.y); xv[i].w = ALPHA_F * bfhi(hw.y) + bfhi(mw.y);
        }
        {
            const int ntok = tok + gridDim.x * 8;
            if (ntok < T_TOK) {
#pragma unroll
                for (int i = 0; i < 8; ++i) { hn[i] = *(const uint2*)(h0b + (size_t)ntok * DM + i * 256 + lane * 4); mn[i] = *(const uint2*)(mixb + (size_t)ntok * DM + i * 256 + lane * 4); } }
        }
        float s = 0.f;
#pragma unroll
        for (int i = 0; i < 8; ++i) s += (xv[i].x + xv[i].y) + (xv[i].z + xv[i].w);
        const float mean = wsum(s) * (1.0f / 2048.0f);
        float q = 0.f;
#pragma unroll
        for (int i = 0; i < 8; ++i) { xv[i].x -= mean; xv[i].y -= mean; xv[i].z -= mean; xv[i].w -= mean; q += xv[i].x * xv[i].x + xv[i].y * xv[i].y + xv[i].z * xv[i].z + xv[i].w * xv[i].w; }
        const float rstd = rsqrtf(wsum(q) * (1.0f / 2048.0f) + LN_EPS_F);
        float amx = 0.f;
#pragma unroll
        for (int i = 0; i < 8; ++i) {
            const float4 g4 = lg[i], b4 = lb[i];
            float4 y; y.x = xv[i].x * rstd * g4.x + b4.x; y.y = xv[i].y * rstd * g4.y + b4.y; y.z = xv[i].z * rstd * g4.z + b4.z; y.w = xv[i].w * rstd * g4.w + b4.w;
            uint2 w; w.x = pk2(y.x, y.y); w.y = pk2(y.z, y.w);
            *(uint2*)(h1b + (size_t)tok * DM + i * 256 + lane * 4) = w;
            xv[i] = y; amx = fmaxf(amx, fmaxf(fmaxf(fabsf(y.x), fabsf(y.y)), fmaxf(fabsf(y.z), fabsf(y.w))));
        }
        amx = wmaxf(amx);
        {
            const float qs = amx > 0.f ? 127.0f / amx : 0.f;
#pragma unroll
            for (int i = 0; i < 8; ++i) {
                const int q0 = (int)rintf(xv[i].x * qs), q1 = (int)rintf(xv[i].y * qs), q2 = (int)rintf(xv[i].z * qs), q3 = (int)rintf(xv[i].w * qs);
                *(unsigned*)(h1f8 + (size_t)tok * DM + i * 256 + lane * 4) = (unsigned)(q0 & 255) | ((unsigned)(q1 & 255) << 8) | ((unsigned)(q2 & 255) << 16) | ((unsigned)(q3 & 255) << 24);
            }
            if (lane == 0) xsc[tok] = amx * (1.0f / 127.0f);
        }
        if (lane == 0) *(float2*)(lns + (size_t)tok * 2) = make_float2(mean, rstd);
    }
}

__device__ __forceinline__ int f2key(float f) { const int b = __float_as_int(f); return b ^ ((b >> 31) & 0x7fffffff); }
__device__ __forceinline__ float key2f(int k) { return __int_as_float(k ^ ((k >> 31) & 0x7fffffff)); }
__device__ __forceinline__ void ce_desc(int& a, int& b) { const int hi = max(a, b), lo = min(a, b); a = hi; b = lo; }
template <int OFF> __device__ __forceinline__ void sort16_desc(int (&v)[64]) {
#pragma unroll
    for (int k = 2; k <= 16; k <<= 1)
#pragma unroll
        for (int j = k >> 1; j > 0; j >>= 1)
#pragma unroll
            for (int i = 0; i < 16; ++i) { const int l = i ^ j; if (l > i) { if ((i & k) == 0) ce_desc(v[OFF + i], v[OFF + l]); else ce_desc(v[OFF + l], v[OFF + i]); } }
}
template <int OA, int OB> __device__ __forceinline__ void merge16_desc(int (&v)[64]) {
#pragma unroll
    for (int i = 0; i < 16; ++i) v[OA + i] = max(v[OA + i], v[OB + 15 - i]);
#pragma unroll
    for (int j = 8; j > 0; j >>= 1)
#pragma unroll
        for (int i = 0; i < 16; ++i) { const int l = i ^ j; if (l > i) ce_desc(v[OA + i], v[OA + l]); }
}
__device__ __forceinline__ void top16_of_64(int (&v)[64]) {
    sort16_desc<0>(v); sort16_desc<16>(v); sort16_desc<32>(v); sort16_desc<48>(v);
    merge16_desc<0, 16>(v); merge16_desc<32, 48>(v); merge16_desc<0, 32>(v);
}

__device__ void phase_select(const Params& p, unsigned char* smem) {
    const int tid = threadIdx.x, lane = tid & 63, wave = tid >> 6;
    const u16* qb = (const u16*)(p.ws + OFF_QB); const u16* keyb = (const u16*)(p.ws + OFF_KEYB);
    int* eidp = (int*)(p.ws + OFF_EID); float* gwp = (float*)(p.ws + OFF_GW);
    u16* key_s = (u16*)smem;
    unsigned char* lut = smem + 69632 + wave * 2048 + lane * 32;
    const int col = lane & 31, hi = lane >> 5;
    const int h = blockIdx.x & 7;
    const int nb = (gridDim.x + 7 - h) >> 3;
    for (int i = tid; i < 4096; i += 512) { const int r = i >> 4, c8 = (i & 15) * 8; *(uint4*)(key_s + r * 136 + c8) = *(const uint4*)(keyb + (size_t)(h * 256 + r) * 128 + c8); }
    __syncthreads();
    for (int tile = (blockIdx.x >> 3) + nb * wave; tile < 1024; tile += nb * 8) {
        const int t0 = tile * 32;
        int sv[2][16];
#pragma unroll
        for (int pp = 0; pp < 2; ++pp) {
            bf16x8 bq[8];
#pragma unroll
            for (int kk = 0; kk < 8; ++kk) bq[kk] = *(const bf16x8*)(qb + (size_t)(t0 + col) * DM + h * 256 + pp * 128 + kk * 16 + hi * 8);
            f32x16 acc[4];
#pragma unroll
            for (int mt = 0; mt < 4; ++mt)
#pragma unroll
                for (int r = 0; r < 16; ++r) acc[mt][r] = 0.f;
            const u16* kb = key_s + pp * 128 * 136;
#pragma unroll
            for (int kk = 0; kk < 8; ++kk) {
#pragma unroll
                for (int mt = 0; mt < 4; ++mt) {
                    const bf16x8 ak = *(const bf16x8*)(kb + (mt * 32 + col) * 136 + kk * 16 + hi * 8);
                    acc[mt] = __builtin_amdgcn_mfma_f32_32x32x16_bf16(ak, bq[kk], acc[mt], 0, 0, 0);
                }
            }
            int v[64];
#pragma unroll
            for (int mt = 0; mt < 4; ++mt)
#pragma unroll
                for (int r = 0; r < 16; ++r) { const int n = 32 * mt + 8 * (r >> 2) + (r & 3) + 4 * hi; v[mt * 16 + r] = (f2key(acc[mt][r]) & ~127) | n; }
            top16_of_64(v);
#pragma unroll
            for (int i = 0; i < 16; ++i) v[16 + i] = __shfl_xor(v[i], 32);
            merge16_desc<0, 16>(v);
#pragma unroll
            for (int i = 0; i < 16; ++i) sv[pp][i] = v[i];
        }
        float f0[16], f1[16];
#pragma unroll
        for (int i = 0; i < 16; ++i) { f0[i] = key2f(sv[0][i] & ~127); f1[i] = key2f(sv[1][i] & ~127); lut[i] = (unsigned char)(sv[0][i] & 127); lut[16 + i] = (unsigned char)(sv[1][i] & 127); }
        int v[64]; int cnt = 0;
#pragma unroll
        for (int a = 0; a < 16; ++a)
#pragma unroll
            for (int b = 0; b < 16; ++b)
                if ((a + 1) * (b + 1) <= 16) { v[cnt] = (f2key(f0[a] + f1[b]) & ~255) | (a * 16 + b); ++cnt; }
#pragma unroll
        for (int i = 50; i < 64; ++i) v[i] = f2key(-1e30f);
        top16_of_64(v);
        float ev[16]; float ssum = 0.f; const float mx = key2f(v[0] & ~255);
#pragma unroll
        for (int k = 0; k < 16; ++k) { ev[k] = __expf(key2f(v[k] & ~255) - mx); ssum += ev[k]; }
        const float inv = 1.0f / ssum;
        const size_t ob = ((size_t)(t0 + col) * 8 + h) * 16;
#pragma unroll
        for (int k = 0; k < 16; ++k) {
            const int code = v[k] & 255;
            const int i0 = lut[code >> 4], i1 = lut[16 + (code & 15)];
            if ((k >> 3) == hi) { eidp[ob + k] = i0 * 128 + i1; gwp[ob + k] = ev[k] * inv; }
        }
    }
}

struct ExpCtx { const u16* h1b; const unsigned char* tab; const int* eid_s; float* part_s; float* out; const float* lns; const float* g1; const float* b1; const u16* h0b; const u16* mixb; const unsigned char* h1f8; int tbase, lane, j, g, rot; };
__device__ __forceinline__ void exp_load(const ExpCtx& c, int step, uint4 (&seg)[16]) {
    const int cb = ((step >> 4) + c.rot) & 15, tt = step & 15;
    const unsigned char* ts = c.tab + (size_t)cb * SLICE_BYTES;
    const unsigned go = (unsigned)c.g * 16u;
    int e[16];
#pragma unroll
    for (int m = 0; m < 4; ++m) { const int4 v = *(const int4*)(c.eid_s + tt * 128 + c.j * 16 + m * 4); e[m * 4] = v.x; e[m * 4 + 1] = v.y; e[m * 4 + 2] = v.z; e[m * 4 + 3] = v.w; }
#pragma unroll
    for (int i = 0; i < 16; ++i) seg[i] = *(const uint4*)(ts + ((unsigned)e[i] * 128u + go));
}
__device__ __forceinline__ void u_loadx(const ExpCtx& c, int step, uint4 (&xw)[2]) {
    const int cb = ((step >> 4) + c.rot) & 15, tt = step & 15;
    xw[0] = *(const uint4*)(c.h1f8 + (size_t)(c.tbase + tt) * DM + cb * 128 + c.g * 16);
}
__device__ __forceinline__ void u_compute(const ExpCtx& c, int step, const uint4 (&seg)[16], const uint4 (&xw)[2]) {
    const int cb = ((step >> 4) + c.rot) & 15, tt = step & 15, lane = c.lane;
    const int x0 = (int)xw[0].x, x1 = (int)xw[0].y, x2 = (int)xw[0].z, x3 = (int)xw[0].w;
    int part[16];
#pragma unroll
    for (int i = 0; i < 16; ++i) {
        int a = __builtin_amdgcn_sdot4((int)seg[i].x, x0, 0, false);
        a = __builtin_amdgcn_sdot4((int)seg[i].y, x1, a, false);
        a = __builtin_amdgcn_sdot4((int)seg[i].z, x2, a, false);
        part[i] = __builtin_amdgcn_sdot4((int)seg[i].w, x3, a, false);
    }
    const bool up2 = (lane & 4) != 0, up1 = (lane & 2) != 0, up0 = (lane & 1) != 0;
#pragma unroll
    for (int i = 0; i < 8; ++i) { const int a = part[i], b = part[i + 8]; part[i] = (up2 ? b : a) + __shfl_xor(up2 ? a : b, 4); }
#pragma unroll
    for (int i = 0; i < 4; ++i) { const int a = part[i], b = part[i + 4]; part[i] = (up1 ? b : a) + __shfl_xor(up1 ? a : b, 2); }
#pragma unroll
    for (int i = 0; i < 2; ++i) { const int a = part[i], b = part[i + 2]; part[i] = (up0 ? b : a) + __shfl_xor(up0 ? a : b, 1); }
    int2* ps = (int2*)(c.part_s + tt * 128 + 2 * lane);
    int2 o = make_int2(part[0], part[1]);
    if ((step >> 4) != 0) { const int2 old = *ps; o.x += old.x; o.y += old.y; }
    *ps = o;
}
struct VRes { unsigned hw, mw; float2 st; };
__device__ __forceinline__ void v_loadres(const ExpCtx& c, int step, VRes& r) {
    const int cb = ((step >> 4) + c.rot) & 15, tt = step & 15; const int co = cb * 128 + c.g * 16 + 2 * c.j;
    r.hw = *(const unsigned*)(c.h0b + (size_t)(c.tbase + tt) * DM + co); r.mw = *(const unsigned*)(c.mixb + (size_t)(c.tbase + tt) * DM + co);
    r.st = *(const float2*)(c.lns + (size_t)(c.tbase + tt) * 2);
}
__device__ __forceinline__ void v_compute(const ExpCtx& c, int step, const uint4 (&seg)[16], const VRes& vr, float2& g1, float2& b1) {
    const int cb = ((step >> 4) + c.rot) & 15, tt = step & 15, lane = c.lane;
    f32x2 acc[8];
#pragma unroll
    for (int k = 0; k < 8; ++k) acc[k] = (f32x2){0.f, 0.f};
#pragma unroll
    for (int m = 0; m < 4; ++m) {
        const float4 f = *(const float4*)(c.part_s + tt * 128 + c.j * 16 + m * 4);
        const float wv[4] = {f.x, f.y, f.z, f.w};
#pragma unroll
        for (int ii = 0; ii < 4; ++ii) {
            const int i = m * 4 + ii;
            const unsigned w[4] = {seg[i].x, seg[i].y, seg[i].z, seg[i].w};
            const f32x2 w2 = (f32x2){wv[ii], wv[ii]};
#pragma unroll
            for (int d = 0; d < 4; ++d) { acc[2 * d] += w2 * __builtin_amdgcn_cvt_pk_f32_fp8((int)w[d], false); acc[2 * d + 1] += w2 * __builtin_amdgcn_cvt_pk_f32_fp8((int)w[d], true); }
        }
    }
    float v[16];
#pragma unroll
    for (int k = 0; k < 8; ++k) { v[2 * k] = acc[k].x; v[2 * k + 1] = acc[k].y; }
    const bool up5 = (lane & 32) != 0, up4 = (lane & 16) != 0, up3 = (lane & 8) != 0;
#pragma unroll
    for (int i = 0; i < 8; ++i) { const float a = v[i], b = v[i + 8]; v[i] = (up5 ? b : a) + __shfl_xor(up5 ? a : b, 32); }
#pragma unroll
    for (int i = 0; i < 4; ++i) { const float a = v[i], b = v[i + 4]; v[i] = (up4 ? b : a) + __shfl_xor(up4 ? a : b, 16); }
#pragma unroll
    for (int i = 0; i < 2; ++i) { const float a = v[i], b = v[i + 2]; v[i] = (up3 ? b : a) + __shfl_xor(up3 ? a : b, 8); }
    const int co = cb * 128 + c.g * 16 + 2 * c.j;
    float2* op = (float2*)(c.out + (size_t)(c.tbase + tt) * DM + co);
    const float2 hh = make_float2(ALPHA_F * bflo(vr.hw) + bflo(vr.mw), ALPHA_F * bfhi(vr.hw) + bfhi(vr.mw));
    const float2 st = vr.st;
    if (tt == 0) { g1 = *(const float2*)(c.g1 + co); b1 = *(const float2*)(c.b1 + co); }
    *op = make_float2(ALPHA_F * ((hh.x - st.x) * st.y * g1.x + b1.x) + v[0], ALPHA_F * ((hh.y - st.x) * st.y * g1.y + b1.y) + v[1]);
}

__device__ void phase_experts(const Params& p, unsigned char* smem) {
    const int tid = threadIdx.x, lane = tid & 63, wave = tid >> 6;
    const float* usc = (const float*)(p.ws + OFF_USC); const float* vsc = (const float*)(p.ws + OFF_VSC);
    const int* eidp = (const int*)(p.ws + OFF_EID); const float* gwp = (const float*)(p.ws + OFF_GW); const float* xsc = (const float*)(p.ws + OFF_XSC);
    int* eid_s = (int*)smem + wave * 2048;
    float* part_s = (float*)(smem + 65536) + wave * 2048;
    ExpCtx c; c.h1b = (const u16*)(p.ws + OFF_H1B); c.eid_s = eid_s; c.part_s = part_s; c.out = p.out; c.lns = (const float*)(p.ws + OFF_LNS); c.g1 = p.ln1_g; c.b1 = p.ln1_b; c.h0b = (const u16*)(p.ws + OFF_H0B); c.mixb = (const u16*)(p.ws + OFF_MIXB); c.h1f8 = p.ws + OFF_H1F8; c.lane = lane; c.j = lane >> 3; c.g = lane & 7;
    c.rot = (int)((__builtin_amdgcn_s_getreg((3 << 11) | 20) & 7u) * 2u);
    for (int tg = blockIdx.x; tg < 256; tg += gridDim.x) {
        const int tbase = tg * 128 + wave * 16; c.tbase = tbase;
#pragma unroll
        for (int k = 0; k < 8; ++k) *(uint4*)(eid_s + k * 256 + lane * 4) = *(const uint4*)(eidp + (size_t)tbase * 128 + k * 256 + lane * 4);
#if defined(PROBE_DUP) && PROBE_DUP == 90
#pragma unroll 1
        for (int urep = 0; urep < 2; ++urep)
#endif
        {
            c.tab = p.ws + OFF_UBF;
            uint4 segA[16], segB[16], xA[2], xB[2];
            exp_load(c, 0, segA); u_loadx(c, 0, xA);
#pragma unroll 1
            for (int step = 0; step < 256; step += 2) {
                exp_load(c, step + 1, segB); u_loadx(c, step + 1, xB);
                u_compute(c, step, segA, xA);
                if (step + 2 < 256) { exp_load(c, step + 2, segA); u_loadx(c, step + 2, xA); }
                u_compute(c, step + 1, segB, xB);
            }
        }
#pragma unroll 1
        for (int tt = 0; tt < 16; ++tt) {
            const int t = tbase + tt;
            const int2 ee = *(const int2*)(eid_s + tt * 128 + 2 * lane);
            const float2 gw = *(const float2*)(gwp + (size_t)t * 128 + 2 * lane);
            float2* ps = (float2*)(part_s + tt * 128 + 2 * lane);
            const int2 pi2 = *(const int2*)ps; const float xs = xsc[t];
            const float a0 = (float)pi2.x * (usc[ee.x] * xs), a1 = (float)pi2.y * (usc[ee.y] * xs);
            float2 o;
            o.x = gw.x * vsc[ee.x] * 0.5f * a0 * (1.0f + erff(a0 * 0.70710678118654752f));
            o.y = gw.y * vsc[ee.y] * 0.5f * a1 * (1.0f + erff(a1 * 0.70710678118654752f));
            *ps = o;
        }
        {
            c.tab = p.ws + OFF_VBF;
            uint4 segA[16], segB[16]; VRes rA, rB; float2 g1 = make_float2(0.f, 0.f), b1 = make_float2(0.f, 0.f);
            exp_load(c, 0, segA); v_loadres(c, 0, rA);
#pragma unroll 1
            for (int step = 0; step < 256; step += 2) {
                exp_load(c, step + 1, segB); v_loadres(c, step + 1, rB);
                v_compute(c, step, segA, rA, g1, b1);
                if (step + 2 < 256) { exp_load(c, step + 2, segA); v_loadres(c, step + 2, rA); }
                v_compute(c, step + 1, segB, rB, g1, b1);
            }
        }
        float4 l2g[8], l2b[8];
#pragma unroll
        for (int i = 0; i < 8; ++i) { l2g[i] = *(const float4*)(p.ln2_g + i * 256 + lane * 4); l2b[i] = *(const float4*)(p.ln2_b + i * 256 + lane * 4); }
        float4 xnx[8];
#pragma unroll
        for (int i = 0; i < 8; ++i) xnx[i] = *(const float4*)(p.out + (size_t)tbase * DM + i * 256 + lane * 4);
#pragma unroll 1
        for (int tt = 0; tt < 16; ++tt) {
            float4 xv[8]; float* xr = p.out + (size_t)(tbase + tt) * DM;
#pragma unroll
            for (int i = 0; i < 8; ++i) xv[i] = xnx[i];
            if (tt + 1 < 16) {
#pragma unroll
                for (int i = 0; i < 8; ++i) xnx[i] = *(const float4*)(xr + DM + i * 256 + lane * 4); }
            float s = 0.f;
#pragma unroll
            for (int i = 0; i < 8; ++i) s += (xv[i].x + xv[i].y) + (xv[i].z + xv[i].w);
            const float mean = wsum(s) * (1.0f / 2048.0f);
            float q = 0.f;
#pragma unroll
            for (int i = 0; i < 8; ++i) { xv[i].x -= mean; xv[i].y -= mean; xv[i].z -= mean; xv[i].w -= mean; q += xv[i].x * xv[i].x + xv[i].y * xv[i].y + xv[i].z * xv[i].z + xv[i].w * xv[i].w; }
            const float rstd = rsqrtf(wsum(q) * (1.0f / 2048.0f) + LN_EPS_F);
#pragma unroll
            for (int i = 0; i < 8; ++i) {
                const float4 g4 = l2g[i], b4 = l2b[i];
                float4 y; y.x = xv[i].x * rstd * g4.x + b4.x; y.y = xv[i].y * rstd * g4.y + b4.y; y.z = xv[i].z * rstd * g4.z + b4.z; y.w = xv[i].w * rstd * g4.w + b4.w;
                *(float4*)(xr + i * 256 + lane * 4) = y;
            }
        }
    }
}

__global__ __launch_bounds__(512, 2) void mega(Params p, int lo, int hi) {
    extern __shared__ __attribute__((aligned(16))) unsigned char smem[];
    cg::grid_group grid = cg::this_grid();
#ifndef PROBE_DUP
#define PROBE_DUP -1
#endif
    __shared__ uint4 xb_words;
    unsigned* bar = (unsigned*)(p.ws + OFF_BAR);
    if (blockIdx.x == 0) for (int i = threadIdx.x; i < XCD_BAR_WORDS; i += 512) bar[i] = 0u;
    if (threadIdx.x == 0) xb_words = make_uint4(0u, 0u, 0u, 0u);
    __syncthreads();
    XcdBarrier xb; xb.bar = bar; xb.x = 0u; xb.st = (volatile LAS unsigned*)&xb_words;
#define SEAM(i) do { if ((i) == 0) { grid.sync(); xb = xcd_barrier_post(bar, (volatile LAS unsigned*)&xb_words); } else xcd_barrier(xb); } while (0)
#define PH_BEGIN(i) if ((i) >= lo && (i) < hi) for (int rep_ = 0; rep_ < (((i) == PROBE_DUP) ? 2 : 1); ++rep_) { if (rep_) { if ((i) == 0) grid.sync(); else xcd_barrier(xb); }
#define PH_END(i) } if ((i) + 1 > lo && (i) + 1 < hi) SEAM(i);
    PH_BEGIN(0) phase_prep(p, smem); PH_END(0)
    PH_BEGIN(1) {
        pg8::Gemm g{(const pg8::bf16_t*)(p.ws + OFF_H0B), (const pg8::bf16_t*)(p.ws + OFF_WINT), T_TOK, NPJ, DM};
        pg8::StaticOrder S; S.init(g.M, g.N, (int)gridDim.x, (int)blockIdx.x);
        pg8::EpiBf16<0> E{(pg8::bf16_t*)(p.ws + OFF_PROJ), NPJ, nullptr, 0, 0};
        pg8::gemm_phase<pg8::EpiBf16<0>, pg8::StaticOrder, false>((PG8_LAS unsigned char*)smem, g, S, E, nullptr);
    } PH_END(1)
    PH_BEGIN(2) phase_conv_local(p, smem); PH_END(2)
    PH_BEGIN(3) phase_scan(p); PH_END(3)
    PH_BEGIN(4) phase_mlstm_out(p, smem); PH_END(4)
    PH_BEGIN(5) {
        pg8::Gemm g{(const pg8::bf16_t*)(p.ws + OFF_YMIX), (const pg8::bf16_t*)(p.ws + OFF_WOUTT), T_TOK, DM, DM};
        pg8::StaticOrder S; S.init(g.M, g.N, (int)gridDim.x, (int)blockIdx.x);
        pg8::EpiBf16<0> E{(pg8::bf16_t*)(p.ws + OFF_MIXB), DM, nullptr, 0, 0};
        pg8::gemm_phase<pg8::EpiBf16<0>, pg8::StaticOrder, false>((PG8_LAS unsigned char*)smem, g, S, E, nullptr);
    } PH_END(5)
    PH_BEGIN(6) phase_ln1(p); PH_END(6)
    PH_BEGIN(7) {
        pg8::Gemm g{(const pg8::bf16_t*)(p.ws + OFF_H1B), (const pg8::bf16_t*)(p.ws + OFF_WQT), T_TOK, DM, DM};
        pg8::StaticOrder S; S.init(g.M, g.N, (int)gridDim.x, (int)blockIdx.x);
        pg8::EpiBf16<0> E{(pg8::bf16_t*)(p.ws + OFF_QB), DM, nullptr, 0, 0};
        pg8::gemm_phase<pg8::EpiBf16<0>, pg8::StaticOrder, false>((PG8_LAS unsigned char*)smem, g, S, E, nullptr);
    } PH_END(7)
    PH_BEGIN(8) phase_select(p, smem); PH_END(8)
    PH_BEGIN(9) phase_experts(p, smem); PH_END(9)
#if PROBE_DUP == 100
    for (int r_ = 0; r_ < 20; ++r_) xcd_barrier(xb);
#endif
}

#define LDS_BYTES 131072
extern "C" void kernel_launch(void* const* d_in, const int* in_sizes, int n_in, void* d_out, int out_size, void* d_ws, size_t ws_size, hipStream_t stream) {
    static int grid_blocks = 0;
    if (!grid_blocks) {
        hipFuncSetAttribute((const void*)mega, hipFuncAttributeMaxDynamicSharedMemorySize, LDS_BYTES);
        int dev = 0, cus = 0, per_cu = 0;
        hipGetDevice(&dev);
        hipDeviceGetAttribute(&cus, hipDeviceAttributeMultiprocessorCount, dev);
        hipOccupancyMaxActiveBlocksPerMultiprocessor(&per_cu, mega, 512, LDS_BYTES);
        if (per_cu < 1) per_cu = 1;
        grid_blocks = cus * per_cu;
        if (grid_blocks > 256) grid_blocks = 256;
    }
    if (ws_size < (size_t)1011 * 1024 * 1024) { fprintf(stderr, "workspace too small: %zu\n", ws_size); return; }
    Params p{};
    p.x = (const float*)d_in[0]; p.ln_in_g = (const float*)d_in[1]; p.ln_in_b = (const float*)d_in[2]; p.w_in = (const float*)d_in[3]; p.b_gate = (const float*)d_in[4];
    p.conv_w = (const float*)d_in[5]; p.conv_b = (const float*)d_in[6]; p.mh_g = (const float*)d_in[7]; p.w_out = (const float*)d_in[8]; p.ln1_g = (const float*)d_in[9]; p.ln1_b = (const float*)d_in[10];
    p.wq = (const float*)d_in[11]; p.keys = (const float*)d_in[12]; p.pu = (const float*)d_in[13]; p.pv = (const float*)d_in[14]; p.ln2_g = (const float*)d_in[15]; p.ln2_b = (const float*)d_in[16];
    p.out = (float*)d_out; p.ws = (unsigned char*)d_ws;
#ifdef MULTI_LAUNCH
    for (int i = 0; i < 10; ++i) { hipLaunchKernelGGL(mega, dim3(grid_blocks), dim3(512), LDS_BYTES, stream, p, i, i + 1); }
#else
    int lo = 0, hi = 10;
    void* args[] = {&p, &lo, &hi};
    hipError_t e = hipLaunchCooperativeKernel((void*)mega, dim3(grid_blocks), dim3(512), args, LDS_BYTES, stream);
    if (e != hipSuccess) fprintf(stderr, "cooperative launch failed: %s (grid %d)\n", hipGetErrorString(e), grid_blocks);
#endif
}
```

```cpp
#include <hip/hip_runtime.h>
#include <hip/hip_cooperative_groups.h>
#include <cstdio>
namespace cg = cooperative_groups;

typedef unsigned short u16;
typedef float f32x16 __attribute__((ext_vector_type(16)));
typedef float f32x2 __attribute__((ext_vector_type(2)));

#define T_TOK 32768
#define SEQ_L 16384
#define DM 2048
#define DIN 7184
#define NPJ 7168
#define ALPHA_F 1.189207115002721f
#define LN_EPS_F 1e-5f
#define QK_SCALE 0.08838834764831845f
#define SLICE_BYTES ((size_t)16384 * 128)

#define MIB ((size_t)1 << 20)
#define OFF_H0B   (0 * MIB)
#define OFF_PROJ  (128 * MIB)
#define OFF_YMIX  (576 * MIB)
#define OFF_H1B   (704 * MIB)
#define OFF_WINT  (832 * MIB)
#define OFF_WOUTT (860 * MIB)
#define OFF_WQT   (868 * MIB)
#define OFF_KEYB  (876 * MIB)
#define OFF_UBF   (877 * MIB)
#define OFF_VBF   (941 * MIB)
#define OFF_GATES (1005 * MIB)
#define OFF_DN    (1007 * MIB)
#define OFF_MG    (1009 * MIB)
#define OFF_BL    (1009 * MIB + 65536)
#define OFF_MST   (1009 * MIB + 131072)
#define OFF_USC   (1009 * MIB + 196608)
#define OFF_VSC   (1009 * MIB + 262144)
#define OFF_LNS   (1009 * MIB + 327680)
#define OFF_XSC   (1009 * MIB + 589824)
#define OFF_BAR   (1010 * MIB)
#define OFF_QB    (128 * MIB)
#define OFF_EID   (256 * MIB)
#define OFF_GW    (272 * MIB)
#define OFF_MIXB  (288 * MIB)
#define OFF_H1F8  (416 * MIB)

struct Params {
    const float *x, *ln_in_g, *ln_in_b, *w_in, *b_gate, *conv_w, *conv_b, *mh_g, *w_out, *ln1_g, *ln1_b, *wq, *keys, *pu, *pv, *ln2_g, *ln2_b;
    float* out; unsigned char* ws;
};

__device__ __forceinline__ unsigned pk2(float lo, float hi) { unsigned r; asm("v_cvt_pk_bf16_f32 %0, %1, %2" : "=v"(r) : "v"(lo), "v"(hi)); return r; }
__device__ __forceinline__ float bflo(unsigned w) { return __uint_as_float(w << 16); }
__device__ __forceinline__ float bfhi(unsigned w) { return __uint_as_float(w & 0xffff0000u); }
__device__ __forceinline__ float bf1(u16 b) { return __uint_as_float(((unsigned)b) << 16); }
__device__ __forceinline__ void unpack8(const uint4 w, float (&f)[8]) {
    f[0] = bflo(w.x); f[1] = bfhi(w.x); f[2] = bflo(w.y); f[3] = bfhi(w.y); f[4] = bflo(w.z); f[5] = bfhi(w.z); f[6] = bflo(w.w); f[7] = bfhi(w.w);
}
__device__ __forceinline__ float wsum(float v) {
#pragma unroll
    for (int o = 32; o; o >>= 1) v += __shfl_xor(v, o);
    return v;
}
__device__ __forceinline__ float wmaxf(float v) {
#pragma unroll
    for (int o = 32; o; o >>= 1) v = fmaxf(v, __shfl_xor(v, o));
    return v;
}
__device__ __forceinline__ float wscan_add(float v, int lane) {
#pragma unroll
    for (int o = 1; o < 64; o <<= 1) { const float t = __shfl_up(v, o); if (lane >= o) v += t; }
    return v;
}
__device__ __forceinline__ float wscan_max(float v, int lane) {
#pragma unroll
    for (int o = 1; o < 64; o <<= 1) { const float t = __shfl_up(v, o); if (lane >= o) v = fmaxf(v, t); }
    return v;
}
#ifndef PROBE_DUP
#define PROBE_DUP -1
#endif
#define XB_TMO      128
#define XB_XCNT(j)  (256  + 64 * (j))
#define XB_XSUB(j)  (1280 + 64 * (j))
#define XB_XGEN(j)  (2304 + 64 * (j))
#define XB_TOP      3328
#define XB_TOPGEN   3392
#define XCD_BAR_WORDS 3456
#define XB_SPIN_CAP (1u << 18)
#define LAS __attribute__((address_space(3)))

__device__ __forceinline__ unsigned xb_ld(unsigned* p)              { return __hip_atomic_load(p, __ATOMIC_RELAXED, __HIP_MEMORY_SCOPE_AGENT); }
__device__ __forceinline__ unsigned xb_add(unsigned* p, unsigned v) { return __hip_atomic_fetch_add(p, v, __ATOMIC_RELAXED, __HIP_MEMORY_SCOPE_AGENT); }
__device__ __forceinline__ unsigned xb_xcc_id() { return (unsigned)__builtin_amdgcn_s_getreg((3 << 11) | 20) & 0xFu; }
#define XB_SPIN(cond, bar) do { unsigned _sp = 0; while (cond) { __builtin_amdgcn_s_sleep(1); \
    if ((++_sp & 255u) == 0u) { if (xb_ld(&(bar)[XB_TMO])) break; if (_sp > XB_SPIN_CAP) { atomicAdd(&(bar)[XB_TMO], 1u); break; } } } } while (0)

struct XcdBarrier {
    unsigned* bar; unsigned x;
    volatile LAS unsigned* st;
};

__device__ __forceinline__ XcdBarrier xcd_barrier_post(unsigned* bar, volatile LAS unsigned* st) {
    XcdBarrier b; b.bar = bar; b.x = xb_xcc_id(); b.st = st;
    if (threadIdx.x == 0) (void)xb_add(&bar[XB_XCNT(b.x)], 1u);
    return b;
}
__device__ __forceinline__ void xcd_barrier_complete(unsigned* bar, unsigned x, unsigned& nloc, unsigned& nx) {
    const unsigned G = gridDim.x * gridDim.y * gridDim.z;
    unsigned sum, cnt, mine, sp = 0u;
    for (;;) {
        sum = 0u; cnt = 0u; mine = 0u;
#pragma unroll
        for (unsigned j = 0; j < 16; ++j) { const unsigned c = xb_ld(&bar[XB_XCNT(j)]); sum += c; cnt += (c > 0u) ? 1u : 0u; mine = (j == x) ? c : mine; }
        if (sum == G) break;
        __builtin_amdgcn_s_sleep(1);
        if ((++sp & 255u) == 0u) { if (xb_ld(&bar[XB_TMO])) break; if (sp > XB_SPIN_CAP) { atomicAdd(&bar[XB_TMO], 1u); break; } }
    }
    nloc = mine > 0u ? mine : 1u; nx = cnt > 0u ? cnt : 1u;
}

__device__ __forceinline__ void xcd_barrier(const XcdBarrier& b) {
    asm volatile("s_waitcnt vmcnt(0)" ::: "memory");
    __syncthreads();
    if (threadIdx.x == 0) {
        unsigned* bar = b.bar;
        __builtin_amdgcn_s_waitcnt(0);
        unsigned nloc = b.st[0], nx = b.st[1];
        if (nloc == 0u) { xcd_barrier_complete(bar, b.x, nloc, nx); b.st[0] = nloc; b.st[1] = nx; }
        const unsigned old = xb_add(&bar[XB_XSUB(b.x)], 1u);
        const unsigned gen = old / nloc;
        if (old + 1u == (gen + 1u) * nloc) {
            __builtin_amdgcn_fence(__ATOMIC_RELEASE, "agent");
            asm volatile("s_waitcnt vmcnt(0)" ::: "memory");
            const unsigned og = xb_add(&bar[XB_TOP], 1u);
            const unsigned tg = og / nx;
            if (og + 1u == (tg + 1u) * nx) xb_add(&bar[XB_TOPGEN], 1u);
            else XB_SPIN(xb_ld(&bar[XB_TOPGEN]) == tg, bar);
            __builtin_amdgcn_fence(__ATOMIC_ACQUIRE, "agent");
            xb_add(&bar[XB_XGEN(b.x)], 1u);
            asm volatile("s_waitcnt vmcnt(0)" ::: "memory");
        } else {
            XB_SPIN(xb_ld(&bar[XB_XGEN(b.x)]) == gen, bar);
            __builtin_amdgcn_fence(__ATOMIC_ACQUIRE, "agent");
            asm volatile("s_waitcnt vmcnt(0)" ::: "memory");
        }
    }
    __syncthreads();
}

namespace pg8 {
#define PG8_LAS __attribute__((address_space(3)))
typedef unsigned short bf16_t;
typedef short bf16x8 __attribute__((ext_vector_type(8)));
typedef float f32x4 __attribute__((ext_vector_type(4)));
typedef unsigned u32x4 __attribute__((ext_vector_type(4)));
constexpr int BM = 256, BK = 64, HALF = 128, HTB = HALF * BK * 2  , STAGE_BYTES = 8 * HTB, NXCD = 8, WGM = 8;

__host__ __device__ __forceinline__ int lds_byte(int r, int c) { const int st = (r >> 4) * 2 + (c >> 5), rr = r & 15, cc = c & 31, ob = rr * 64 + cc * 2; return st * 1024 + (ob ^ (((ob >> 9) & 1) << 5)); }
__host__ __device__ __forceinline__ void stage_rc(int b, int& R, int& C) { const int st = b / 1024, sb = b % 1024, swz = sb ^ (((sb >> 9) & 1) << 5); R = (st >> 1) * 16 + swz / 64; C = (st & 1) * 32 + (swz % 64) / 2; }
__host__ __device__ __forceinline__ int perm32(int rho) { const int n = rho >> 4, i = rho & 15; return 8 * (i >> 2) + 4 * n + (i & 3); }

struct Unit { int pm, pn; };
struct Gemm { const bf16_t* A; const bf16_t* Bt; int M, N, K; };

struct StaticOrder {
    int nM, nN, nwg, G, c;
    __host__ __device__ void init(int M, int N, int G_, int c_) { nM = M / BM; nN = N / BM; nwg = nM * nN; G = G_; c = c_; }
    __host__ __device__ bool next(int i, Unit& u) const {
        const long L = (long)i * G + c; if (L >= nwg) return false;
        int wgid = (int)L; { const int q = nwg / NXCD, r = nwg % NXCD, xcd = wgid % NXCD, off = wgid / NXCD; wgid = (xcd < r ? xcd * (q + 1) : r * (q + 1) + (xcd - r) * q) + off; }
        const int nig = WGM * nN, gid = wgid / nig, fm = gid * WGM, gsz = (nM - fm) < WGM ? (nM - fm) : WGM;
        u.pm = fm + ((wgid % nig) % gsz); u.pn = (wgid % nig) / gsz; return true;
    }
    __device__ __forceinline__ void a_ready(const Unit&) const {}
    __device__ __forceinline__ void done(const Unit&) const {}
};
struct CountedOrder : StaticOrder {
    const unsigned* ready; unsigned need; unsigned* tmo;
    __device__ __forceinline__ void a_ready(const Unit& u) const {
        if (threadIdx.x < 64) {
            const unsigned long long t0 = __builtin_amdgcn_s_memrealtime(); unsigned polls = 0;
            while ((unsigned)__builtin_amdgcn_readfirstlane(__hip_atomic_load(ready + 64 * u.pm, __ATOMIC_RELAXED, __HIP_MEMORY_SCOPE_AGENT)) < need) {
                if ((++polls & 255u) == 0u && __builtin_amdgcn_readfirstlane(__hip_atomic_load(tmo, __ATOMIC_RELAXED, __HIP_MEMORY_SCOPE_AGENT)) != 0u) break;
                if (__builtin_amdgcn_s_memrealtime() - t0 > 2000000ull) {
                    if (threadIdx.x == 0) { unsigned expect = 0u; __hip_atomic_compare_exchange_strong(tmo + 1, &expect, 0x600u | (unsigned)(u.pm & 0xff), __ATOMIC_RELAXED, __ATOMIC_RELAXED, __HIP_MEMORY_SCOPE_AGENT); __hip_atomic_store(tmo, 1u, __ATOMIC_RELAXED, __HIP_MEMORY_SCOPE_AGENT); }
                    break; }
                __builtin_amdgcn_s_sleep(2); }
            __builtin_amdgcn_fence(__ATOMIC_ACQUIRE, "agent");
            asm volatile("s_waitcnt vmcnt(0)" ::: "memory");
        }
#if !defined(BROKEN_HOOK_NO_BARRIER)
        asm volatile("" ::: "memory"); __builtin_amdgcn_s_barrier(); asm volatile("" ::: "memory");
#endif
    }
};

__device__ __forceinline__ unsigned cvt_pk_bf16(float lo, float hi) { unsigned r; asm volatile("v_cvt_pk_bf16_f32 %0, %1, %2" : "=v"(r) : "v"(lo), "v"(hi)); return r; }
typedef float f32x2 __attribute__((ext_vector_type(2)));
__device__ __forceinline__ f32x2 gelu_pk(f32x2 v) {
    const f32x2 av = __builtin_elementwise_abs(v), d = av * 0.2316418882f + 1.0f;
    f32x2 t; t.x = __builtin_amdgcn_rcpf(d.x); t.y = __builtin_amdgcn_rcpf(d.y);
    f32x2 q = t * 0.5307027145f + (-0.7265760135f); q = q * t + 0.7107068705f; q = q * t + (-0.142248368f); q = q * t + 0.127414796f; q = q * t;
    const f32x2 s = (v * v) * (-0.72134752044f);
    f32x2 e; e.x = __builtin_amdgcn_exp2f(s.x); e.y = __builtin_amdgcn_exp2f(s.y);
    const f32x2 m = v * (q * e), r = v - m;
    f32x2 o; o.x = v.x < 0.f ? m.x : r.x; o.y = v.y < 0.f ? m.y : r.y; return o;
}

struct EpiF32 {
    static constexpr bool PERM = false, AFTER_DRAIN = false;
    float* C; int ldc; const float* bias;
    __device__ __forceinline__ void operator()(const f32x4 (&acc)[2][2][4][2], const Unit& u, int wr, int wc, int fr, int fq) const {
        const int row0 = u.pm * BM + wr * 64 + fr, col0 = u.pn * BM + wc * 32 + 4 * fq;
        f32x4 bv[2][2];
#pragma unroll
        for (int bj = 0; bj < 2; ++bj)
#pragma unroll
            for (int n = 0; n < 2; ++n) bv[bj][n] = bias ? *(const f32x4*)(bias + col0 + bj * HALF + n * 16) : (f32x4){0.f, 0.f, 0.f, 0.f};
#pragma unroll
        for (int ai = 0; ai < 2; ++ai)
#pragma unroll
            for (int m = 0; m < 4; ++m) { float* rowp = C + (size_t)(row0 + ai * HALF + m * 16) * ldc + col0;
#pragma unroll
                for (int bj = 0; bj < 2; ++bj)
#pragma unroll
                    for (int n = 0; n < 2; ++n) *(f32x4*)(rowp + bj * HALF + n * 16) = acc[ai][bj][m][n] + bv[bj][n]; }
    }
};
template <int ACT  > struct EpiBf16 {
    static constexpr bool PERM = true, AFTER_DRAIN = false;
    bf16_t* O; int ldc; const float* bias; int split_cols; size_t split_stride; int nt = 0;
    __device__ __forceinline__ void operator()(const f32x4 (&acc)[2][2][4][2], const Unit& u, int wr, int wc, int fr, int fq) const {
        const int row0 = u.pm * BM + wr * 64 + fr; int colt = u.pn * BM; bf16_t* base = O;
        if (split_cols) { const int t = colt / split_cols; base += (size_t)t * split_stride; colt -= t * split_cols; }
        const int col0 = colt + wc * 32 + 8 * fq, bcol0 = u.pn * BM + wc * 32 + 8 * fq;
        f32x4 bv[2][2];
#pragma unroll
        for (int bj = 0; bj < 2; ++bj)
#pragma unroll
            for (int n = 0; n < 2; ++n) bv[bj][n] = bias ? *(const f32x4*)(bias + bcol0 + bj * HALF + 4 * n) : (f32x4){0.f, 0.f, 0.f, 0.f};
#pragma unroll
        for (int ai = 0; ai < 2; ++ai)
#pragma unroll
            for (int m = 0; m < 4; ++m) { bf16_t* rowp = base + (size_t)(row0 + ai * HALF + m * 16) * ldc + col0;
#pragma unroll
                for (int bj = 0; bj < 2; ++bj) { f32x4 v0 = acc[ai][bj][m][0] + bv[bj][0], v1 = acc[ai][bj][m][1] + bv[bj][1];
                    if (ACT == 1) { f32x2 a = gelu_pk((f32x2){v0[0], v0[1]}), b = gelu_pk((f32x2){v0[2], v0[3]}), c = gelu_pk((f32x2){v1[0], v1[1]}), d = gelu_pk((f32x2){v1[2], v1[3]});
                        v0 = (f32x4){a.x, a.y, b.x, b.y}; v1 = (f32x4){c.x, c.y, d.x, d.y}; }
                    if (ACT == 2) {
#pragma unroll
                        for (int j = 0; j < 4; ++j) { v0[j] = 0.5f * v0[j] * (1.0f + erff(v0[j] * 0.70710678f)); v1[j] = 0.5f * v1[j] * (1.0f + erff(v1[j] * 0.70710678f)); } }
                    u32x4 w; w.x = cvt_pk_bf16(v0[0], v0[1]); w.y = cvt_pk_bf16(v0[2], v0[3]); w.z = cvt_pk_bf16(v1[0], v1[1]); w.w = cvt_pk_bf16(v1[2], v1[3]);
                    if (nt) __builtin_nontemporal_store(w, (u32x4*)(rowp + bj * HALF)); else *(u32x4*)(rowp + bj * HALF) = w; } }
    }
};
template <class Epi, class Sched, bool STAMP = false>
__device__ __forceinline__ void gemm_phase(PG8_LAS unsigned char* lds, const Gemm g, const Sched& S, const Epi& E, unsigned long long* stamps) {
    const int tid = threadIdx.x, wid = __builtin_amdgcn_readfirstlane(tid >> 6), lane = tid & 63, wr = wid >> 2, wc = wid & 3, fr = lane & 15, fq = lane >> 4;
    const int K = g.K, nt = K / BK;
    int ts_lo = 0, ts_hi = 0, nts = 0; const unsigned long long rt_entry = STAMP ? (unsigned long long)wall_clock64() : 0ull;
#define PG8_STAMP() do { if (STAMP && wid == 0 && nts < 64) { const unsigned long long _c = (unsigned long long)clock64(); \
        ts_lo = (lane == nts) ? (int)(unsigned)_c : ts_lo; ts_hi = (lane == nts) ? (int)(unsigned)(_c >> 32) : ts_hi; ++nts; } } while (0)
    PG8_STAMP();
    unsigned voffA[2], voffB[2];
#pragma unroll
    for (int i = 0; i < 2; ++i) { int R, C; stage_rc(tid * 16 + i * 8192, R, C); const int Rb = Epi::PERM ? ((R & ~31) + perm32(R & 31)) : R;
        voffA[i] = (unsigned)(R * K + C) * 2u; voffB[i] = (unsigned)(Rb * K + C) * 2u; }
    const size_t kstep = (size_t)(BK * 2);
    const size_t hstep = (size_t)HALF * K * 2;
    const size_t tstep = 2 * hstep;
    const unsigned ldsw = (unsigned)wid * 1024u;
    const int aoff = lds_byte(wr * 64 + fr, fq * 8), boff = lds_byte(wc * 32 + fr, fq * 8);
#define PG8_SA(b, h) (((b) * 2 + (h)) * HTB)
#define PG8_SB(b, h) ((4 + (b) * 2 + (h)) * HTB)
#define PG8_STAGE(bufoff, gbase, voff) do { _Pragma("unroll") for (int _i = 0; _i < 2; ++_i) \
        __builtin_amdgcn_global_load_lds((const unsigned*)((const char*)(gbase) + (voff)[_i]), (PG8_LAS unsigned*)(lds + (bufoff) + ldsw + _i * 8192), 16, 0, 0); } while (0)
#define PG8_LDA(dst, b, h) do { _Pragma("unroll") for (int m = 0; m < 4; ++m) _Pragma("unroll") for (int k = 0; k < 2; ++k) dst[m][k] = *(const PG8_LAS bf16x8*)(lds + PG8_SA(b, h) + aoff + m * 2048 + k * 1024); } while (0)
#define PG8_LDB(dst, b, h) do { _Pragma("unroll") for (int n = 0; n < 2; ++n) _Pragma("unroll") for (int k = 0; k < 2; ++k) dst[n][k] = *(const PG8_LAS bf16x8*)(lds + PG8_SB(b, h) + boff + n * 2048 + k * 1024); } while (0)
#define PG8_MMA(ai, bj, At, Bt) do { __builtin_amdgcn_s_setprio(1); _Pragma("unroll") for (int m = 0; m < 4; ++m) _Pragma("unroll") for (int n = 0; n < 2; ++n) _Pragma("unroll") for (int k = 0; k < 2; ++k) \
        acc[ai][bj][m][n] = __builtin_amdgcn_mfma_f32_16x16x32_bf16(Bt[n][k], At[m][k], acc[ai][bj][m][n], 0, 0, 0); __builtin_amdgcn_s_setprio(0); } while (0)
#define PG8_WAIT_V(n) asm volatile("s_waitcnt vmcnt(" #n ")" ::: "memory")
#define PG8_WAIT_L(n) asm volatile("s_waitcnt lgkmcnt(" #n ")" ::: "memory")
#define PG8_BAR __builtin_amdgcn_s_barrier()
#define PG8_SCHED __builtin_amdgcn_sched_barrier(0)
    Unit cur, nxt; int ui = 0;
    if (!S.next(0, cur)) return;
    f32x4 acc[2][2][4][2];
#pragma unroll
    for (int a = 0; a < 2; ++a)
#pragma unroll
        for (int b = 0; b < 2; ++b)
#pragma unroll
            for (int m = 0; m < 4; ++m)
#pragma unroll
                for (int n = 0; n < 2; ++n) acc[a][b][m][n] = (f32x4){0.f, 0.f, 0.f, 0.f};
    bf16x8 At[4][2], B0[2][2], B1[2][2];
    const char* cA = (const char*)g.A + (size_t)cur.pm * tstep; const char* cB = (const char*)g.Bt + (size_t)cur.pn * tstep;
    S.a_ready(cur);
    PG8_STAGE(PG8_SB(0, 0), cB, voffB); PG8_STAGE(PG8_SA(0, 0), cA, voffA); PG8_STAGE(PG8_SB(0, 1), cB + hstep, voffB); PG8_STAGE(PG8_SA(0, 1), cA + hstep, voffA);
    if (wr == 1) PG8_BAR;
    PG8_WAIT_V(4); PG8_BAR;
    PG8_STAGE(PG8_SB(1, 0), cB + kstep, voffB); PG8_STAGE(PG8_SA(1, 0), cA + kstep, voffA); PG8_STAGE(PG8_SB(1, 1), cB + hstep + kstep, voffB);
    PG8_WAIT_V(6); PG8_BAR;
    PG8_STAMP();
    for (;;) {
        const bool has_next = S.next(ui + 1, nxt);
        const char* nA = has_next ? (const char*)g.A + (size_t)nxt.pm * tstep : cA; const char* nB = has_next ? (const char*)g.Bt + (size_t)nxt.pn * tstep : cB;
        for (int t = 0; t < nt; t += 2) {
            const bool last = (t == nt - 2);
            const char* a1 = cA + (size_t)(t + 1) * kstep;
            const char* a2 = last ? nA : cA + (size_t)(t + 2) * kstep; const char* b2 = last ? nB : cB + (size_t)(t + 2) * kstep;
            const char* a3 = a2 + kstep; const char* b3 = b2 + kstep;
            if (last && has_next) S.a_ready(nxt);
            PG8_LDB(B0, 0, 0); PG8_SCHED; PG8_LDA(At, 0, 0); PG8_STAGE(PG8_SA(1, 1), a1 + hstep, voffA);
            PG8_WAIT_L(8); PG8_BAR; PG8_WAIT_L(0); PG8_MMA(0, 0, At, B0); PG8_BAR; PG8_SCHED;
            PG8_LDB(B1, 0, 1); PG8_STAGE(PG8_SB(0, 0), b2, voffB);
            PG8_BAR; PG8_WAIT_L(0); PG8_MMA(0, 1, At, B1); PG8_BAR;
            PG8_LDA(At, 0, 1); PG8_STAGE(PG8_SA(0, 0), a2, voffA);
            PG8_BAR; PG8_WAIT_L(0); PG8_MMA(1, 0, At, B0); PG8_BAR; PG8_SCHED;
            PG8_STAGE(PG8_SB(0, 1), b2 + hstep, voffB);
            PG8_WAIT_V(6); PG8_BAR; PG8_MMA(1, 1, At, B1); PG8_BAR;
            PG8_LDB(B0, 1, 0); PG8_SCHED; PG8_LDA(At, 1, 0); PG8_STAGE(PG8_SA(0, 1), a2 + hstep, voffA);
            PG8_WAIT_L(8); PG8_BAR; PG8_WAIT_L(0); PG8_MMA(0, 0, At, B0); PG8_BAR; PG8_SCHED;
            PG8_LDB(B1, 1, 1); PG8_STAGE(PG8_SB(1, 0), b3, voffB);
            PG8_BAR; PG8_WAIT_L(0); PG8_MMA(0, 1, At, B1); PG8_BAR;
            PG8_LDA(At, 1, 1); PG8_STAGE(PG8_SA(1, 0), a3, voffA);
            PG8_BAR; PG8_WAIT_L(0); PG8_MMA(1, 0, At, B0); PG8_BAR; PG8_SCHED;
            PG8_STAGE(PG8_SB(1, 1), b3 + hstep, voffB);
            PG8_WAIT_V(6); PG8_BAR; PG8_MMA(1, 1, At, B1); PG8_BAR;
        }
        PG8_STAMP();
        if constexpr (!Epi::AFTER_DRAIN) { E(acc, cur, wr, wc, fr, fq); S.done(cur); }
        PG8_STAMP();
        if (!has_next) break;
#pragma unroll
        for (int a = 0; a < 2; ++a)
#pragma unroll
            for (int b = 0; b < 2; ++b)
#pragma unroll
                for (int m = 0; m < 4; ++m)
#pragma unroll
                    for (int n = 0; n < 2; ++n) acc[a][b][m][n] = (f32x4){0.f, 0.f, 0.f, 0.f};
        cur = nxt; cA = nA; cB = nB; ++ui;
    }
    PG8_WAIT_V(0);
    if (wr == 0) PG8_BAR;
    PG8_BAR;
    if constexpr (Epi::AFTER_DRAIN) { E.fused(acc, cur, wr, wc, fr, fq, lds, wid, lane); S.done(cur); }
    PG8_STAMP();
    if (STAMP && wid == 0) { stamps[lane] = lane < nts ? (((unsigned long long)(unsigned)ts_hi << 32) | (unsigned)ts_lo) : 0ull;
        if (lane == 62) stamps[62] = rt_entry; if (lane == 63) stamps[63] = (unsigned long long)wall_clock64(); }
#undef PG8_STAMP
#undef PG8_SA
#undef PG8_SB
#undef PG8_STAGE
#undef PG8_LDA
#undef PG8_LDB
#undef PG8_MMA
#undef PG8_WAIT_V
#undef PG8_WAIT_L
#undef PG8_BAR
#undef PG8_SCHED
}
}

using pg8::bf16x8; using pg8::f32x4;

__device__ void phase_prep(const Params& p, unsigned char* smem) {
    const int tid = threadIdx.x, lane = tid & 63, wave = tid >> 6;
    u16* winT = (u16*)(p.ws + OFF_WINT); u16* woutT = (u16*)(p.ws + OFF_WOUTT); u16* wqT = (u16*)(p.ws + OFF_WQT);
    float* tile = (float*)smem;
    for (int tg4 = blockIdx.x; tg4 < 1408; tg4 += gridDim.x) {
        float4 v[4][2];
#pragma unroll
        for (int q = 0; q < 4; ++q) {
            const int tl = tg4 * 4 + q;
            const float* src; int ld, kt, nt;
            if (tl < 3584) { src = p.w_in; ld = DIN; kt = tl / 112; nt = tl % 112; }
            else if (tl < 4608) { const int r = tl - 3584; src = p.w_out; ld = DM; kt = r >> 5; nt = r & 31; }
            else { const int r = tl - 4608; src = p.wq; ld = DM; kt = r >> 5; nt = r & 31; }
#pragma unroll
            for (int i = 0; i < 2; ++i) { const int id = tid + i * 512, r = id >> 4, c4 = (id & 15) * 4; v[q][i] = *(const float4*)(src + (size_t)(kt * 64 + r) * ld + nt * 64 + c4); }
        }
#pragma unroll
        for (int q = 0; q < 4; ++q)
#pragma unroll
            for (int i = 0; i < 2; ++i) {
                const int id = tid + i * 512, r = id >> 4, c4 = (id & 15) * 4; float* tq = tile + q * 4160;
                tq[r * 65 + c4 + 0] = v[q][i].x; tq[r * 65 + c4 + 1] = v[q][i].y; tq[r * 65 + c4 + 2] = v[q][i].z; tq[r * 65 + c4 + 3] = v[q][i].w;
            }
        __syncthreads();
#pragma unroll
        for (int q = 0; q < 4; ++q) {
            const int tl = tg4 * 4 + q;
            u16* dst; int kt, nt;
            if (tl < 3584) { dst = winT; kt = tl / 112; nt = tl % 112; }
            else if (tl < 4608) { const int r = tl - 3584; dst = woutT; kt = r >> 5; nt = r & 31; }
            else { const int r = tl - 4608; dst = wqT; kt = r >> 5; nt = r & 31; }
            const int n = tid >> 3, k8 = (tid & 7) * 8; float f[8]; const float* tq = tile + q * 4160;
#pragma unroll
            for (int j = 0; j < 8; ++j) f[j] = tq[(k8 + j) * 65 + n];
            uint4 w; w.x = pk2(f[0], f[1]); w.y = pk2(f[2], f[3]); w.z = pk2(f[4], f[5]); w.w = pk2(f[6], f[7]);
            *(uint4*)(dst + (size_t)(nt * 64 + n) * 2048 + kt * 64 + k8) = w;
        }
        __syncthreads();
    }
    {
        u16* keyb = (u16*)(p.ws + OFF_KEYB);
        for (int i = blockIdx.x * 512 + tid; i < 65536; i += gridDim.x * 512) {
            const float4 v = *(const float4*)(p.keys + (size_t)i * 4);
            uint2 w; w.x = pk2(v.x, v.y); w.y = pk2(v.z, v.w); *(uint2*)(keyb + (size_t)i * 4) = w;
        }
    }
    float* Wg = (float*)smem;
    for (int idx = tid; idx < 32768; idx += 512) { const int k = idx >> 4, g = idx & 15; Wg[g * 2048 + k] = p.w_in[(size_t)k * DIN + NPJ + g]; }
    __syncthreads();
    u16* h0b = (u16*)(p.ws + OFF_H0B); float* gates = (float*)(p.ws + OFF_GATES);
    unsigned char* ub = p.ws + OFF_UBF; unsigned char* vb = p.ws + OFF_VBF; float* usc = (float*)(p.ws + OFF_USC); float* vsc = (float*)(p.ws + OFF_VSC);
    const int G8 = gridDim.x * 8;
    for (int t0 = blockIdx.x * 8 + wave; t0 < T_TOK; t0 += 2 * G8) {
        const int t1 = t0 + G8; const bool has1 = t1 < T_TOK; const int t1c = has1 ? t1 : t0;
        float4 xv[2][8], fr[1][2][4];
#pragma unroll
        for (int i = 0; i < 8; ++i) { xv[0][i] = *(const float4*)(p.x + (size_t)t0 * DM + i * 256 + lane * 4); xv[1][i] = *(const float4*)(p.x + (size_t)t1c * DM + i * 256 + lane * 4); }
#pragma unroll
        for (int u = 0; u < 2; ++u) {
            float s = 0.f;
#pragma unroll
            for (int i = 0; i < 8; ++i) s += (xv[u][i].x + xv[u][i].y) + (xv[u][i].z + xv[u][i].w);
            const float mean = wsum(s) * (1.0f / 2048.0f);
            float q = 0.f;
#pragma unroll
            for (int i = 0; i < 8; ++i) { xv[u][i].x -= mean; xv[u][i].y -= mean; xv[u][i].z -= mean; xv[u][i].w -= mean; q += xv[u][i].x * xv[u][i].x + xv[u][i].y * xv[u][i].y + xv[u][i].z * xv[u][i].z + xv[u][i].w * xv[u][i].w; }
            const float rstd = rsqrtf(wsum(q) * (1.0f / 2048.0f) + LN_EPS_F);
            const int tok = u ? t1c : t0;
#pragma unroll
            for (int i = 0; i < 8; ++i) {
                const float4 g4 = *(const float4*)(p.ln_in_g + i * 256 + lane * 4), b4 = *(const float4*)(p.ln_in_b + i * 256 + lane * 4);
                xv[u][i].x = xv[u][i].x * rstd * g4.x + b4.x; xv[u][i].y = xv[u][i].y * rstd * g4.y + b4.y; xv[u][i].z = xv[u][i].z * rstd * g4.z + b4.z; xv[u][i].w = xv[u][i].w * rstd * g4.w + b4.w;
                uint2 w; w.x = pk2(xv[u][i].x, xv[u][i].y); w.y = pk2(xv[u][i].z, xv[u][i].w);
                if (u == 0 || has1) *(uint2*)(h0b + (size_t)tok * DM + i * 256 + lane * 4) = w;
            }
        }
        {
            const float* src = ((t0 >= 16384) ? p.pv : p.pu) + (size_t)(t0 & 16383) * DM;
#pragma unroll
            for (int i = 0; i < 2; ++i)
#pragma unroll
                for (int m = 0; m < 4; ++m) fr[0][i][m] = *(const float4*)(src + i * 1024 + lane * 16 + m * 4);
        }
        float pa[16], pb[16];
#pragma unroll
        for (int g = 0; g < 16; ++g) {
            float a = 0.f, b = 0.f;
#pragma unroll
            for (int i = 0; i < 8; ++i) {
                const float4 w4 = *(const float4*)(Wg + g * 2048 + i * 256 + lane * 4);
                a += xv[0][i].x * w4.x + xv[0][i].y * w4.y + xv[0][i].z * w4.z + xv[0][i].w * w4.w;
                b += xv[1][i].x * w4.x + xv[1][i].y * w4.y + xv[1][i].z * w4.z + xv[1][i].w * w4.w;
            }
            pa[g] = a; pb[g] = b;
        }
#pragma unroll
        for (int st = 0; st < 4; ++st) {
            const int sft = 32 >> st, n2 = 8 >> st; const bool up = (lane & sft) != 0;
#pragma unroll
            for (int i = 0; i < n2; ++i) {
                const float a0 = pa[i], a1 = pa[i + n2], b0 = pb[i], b1 = pb[i + n2];
                pa[i] = (up ? a1 : a0) + __shfl_xor(up ? a0 : a1, sft);
                pb[i] = (up ? b1 : b0) + __shfl_xor(up ? b0 : b1, sft);
            }
        }
        float va = pa[0], vb2 = pb[0];
        va += __shfl_xor(va, 2); va += __shfl_xor(va, 1); vb2 += __shfl_xor(vb2, 2); vb2 += __shfl_xor(vb2, 1);
        if ((lane & 3) == 0) {
            const int g = ((lane >> 5) & 1) * 8 + ((lane >> 4) & 1) * 4 + ((lane >> 3) & 1) * 2 + ((lane >> 2) & 1);
            const float bg = p.b_gate[g];
            float z0 = va + bg, z1 = vb2 + bg;
            if (g >= 8) { z0 = fminf(z0, 0.f) - log1pf(__expf(-fabsf(z0))); z1 = fminf(z1, 0.f) - log1pf(__expf(-fabsf(z1))); }
            gates[(size_t)t0 * 16 + g] = z0;
            if (has1) gates[(size_t)t1 * 16 + g] = z1;
        }
#pragma unroll
        for (int u = 0; u < 2; ++u) {
            if (u == 1 && !has1) break;
            const int row = u ? t1 : t0; const int r = row & 16383; const bool isv = row >= 16384;
            if (u == 1) {
                const float* src = (isv ? p.pv : p.pu) + (size_t)r * DM;
#pragma unroll
                for (int i = 0; i < 2; ++i)
#pragma unroll
                    for (int m = 0; m < 4; ++m) fr[0][i][m] = *(const float4*)(src + i * 1024 + lane * 16 + m * 4);
            }
            float am = 0.f;
#pragma unroll
            for (int i = 0; i < 2; ++i)
#pragma unroll
                for (int m = 0; m < 4; ++m) am = fmaxf(am, fmaxf(fmaxf(fabsf(fr[0][i][m].x), fabsf(fr[0][i][m].y)), fmaxf(fabsf(fr[0][i][m].z), fabsf(fr[0][i][m].w))));
            am = wmaxf(am);
            int ex = 0; if (am > 0.f) (void)frexpf(am, &ex); else ex = 8;
            const float sc = isv ? ldexpf(1.0f, 8 - ex) : (am > 0.f ? 127.0f / am : 0.f), isc = isv ? ldexpf(1.0f, ex - 8) : am * (1.0f / 127.0f);
#pragma unroll
            for (int i = 0; i < 2; ++i) {
                unsigned w[4];
#pragma unroll
                for (int m = 0; m < 4; ++m) {
                    if (isv) { int t = 0; t = __builtin_amdgcn_cvt_pk_fp8_f32(fr[0][i][m].x * sc, fr[0][i][m].y * sc, t, false); t = __builtin_amdgcn_cvt_pk_fp8_f32(fr[0][i][m].z * sc, fr[0][i][m].w * sc, t, true); w[m] = (unsigned)t; }
                    else { const int q0 = (int)rintf(fr[0][i][m].x * sc), q1 = (int)rintf(fr[0][i][m].y * sc), q2 = (int)rintf(fr[0][i][m].z * sc), q3 = (int)rintf(fr[0][i][m].w * sc);
                        w[m] = (unsigned)(q0 & 255) | ((unsigned)(q1 & 255) << 8) | ((unsigned)(q2 & 255) << 16) | ((unsigned)(q3 & 255) << 24); }
                }
                *(uint4*)((isv ? vb : ub) + (size_t)(i * 8 + (lane >> 3)) * SLICE_BYTES + (size_t)r * 128 + (lane & 7) * 16) = make_uint4(w[0], w[1], w[2], w[3]);
            }
            if (lane == 0) (isv ? vsc : usc)[r] = isc;
        }
    }
}

__device__ void phase_conv_local(const Params& p, unsigned char* smem) {
    const int tid = threadIdx.x, lane = tid & 63, wave = tid >> 6;
    const u16* proj = (const u16*)(p.ws + OFF_PROJ); u16* ymix = (u16*)(p.ws + OFF_YMIX);
#if PROBE_DUP == 20
    for (int prep_ = 0; prep_ < 2; ++prep_)
#endif
    for (int task = blockIdx.x * 512 + tid; task < 131072; task += gridDim.x * 512) {
        const int cgp = task & 127, run = task >> 7, t0 = run * 32, c0 = cgp * 8;
        float w0[8], w1[8], w2[8], bb[8], z1[8], z2[8];
#pragma unroll
        for (int j = 0; j < 8; ++j) { w0[j] = p.conv_w[c0 + j]; w1[j] = p.conv_w[1024 + c0 + j]; w2[j] = p.conv_w[2048 + c0 + j]; bb[j] = p.conv_b[c0 + j]; z1[j] = 0.f; z2[j] = 0.f; }
        if ((t0 & (SEQ_L - 1)) != 0) {
            float a[8], b[8];
            unpack8(*(const uint4*)(proj + (size_t)(t0 - 2) * NPJ + 1024 + c0), a); unpack8(*(const uint4*)(proj + (size_t)(t0 - 2) * NPJ + 2048 + c0), b);
#pragma unroll
            for (int j = 0; j < 8; ++j) z2[j] = a[j] * b[j];
            unpack8(*(const uint4*)(proj + (size_t)(t0 - 1) * NPJ + 1024 + c0), a); unpack8(*(const uint4*)(proj + (size_t)(t0 - 1) * NPJ + 2048 + c0), b);
#pragma unroll
            for (int j = 0; j < 8; ++j) z1[j] = a[j] * b[j];
        }
#pragma unroll 1
        for (int tb = t0; tb < t0 + 32; tb += 8) {
            uint4 rb[8], rc[8], rh[8];
#pragma unroll
            for (int u = 0; u < 8; ++u) { rb[u] = *(const uint4*)(proj + (size_t)(tb + u) * NPJ + c0); rc[u] = *(const uint4*)(proj + (size_t)(tb + u) * NPJ + 1024 + c0); rh[u] = *(const uint4*)(proj + (size_t)(tb + u) * NPJ + 2048 + c0); }
#pragma unroll
            for (int u = 0; u < 8; ++u) {
                float cb[8], cc[8], ch[8], y[8];
                unpack8(rb[u], cb); unpack8(rc[u], cc); unpack8(rh[u], ch);
#pragma unroll
                for (int j = 0; j < 8; ++j) { const float z = cc[j] * ch[j]; y[j] = cb[j] * (bb[j] + w0[j] * z2[j] + w1[j] * z1[j] + w2[j] * z); z2[j] = z1[j]; z1[j] = z; }
                uint4 w; w.x = pk2(y[0], y[1]); w.y = pk2(y[2], y[3]); w.z = pk2(y[4], y[5]); w.w = pk2(y[6], y[7]);
                *(uint4*)(ymix + (size_t)(tb + u) * DM + c0) = w;
            }
        }
    }
    const float* gates = (const float*)(p.ws + OFF_GATES);
    u16* dC = (u16*)p.out; float* dn = (float*)(p.ws + OFF_DN); float* MG = (float*)(p.ws + OFF_MG); float* BL = (float*)(p.ws + OFF_BL);
    u16* KT = (u16*)smem;
    u16* VT = (u16*)(smem + 18432);
    float* wk_s = (float*)(smem + 36864);
    uint4 kv[2], vv[2]; float li = 0.f, lf = 0.f;
#if PROBE_DUP == 21
    for (int prep_ = 0; prep_ < 2; ++prep_) {
#endif
    {
        const int it0 = blockIdx.x;
        if (it0 < 4096) {
            const int bh = it0 >> 8, c = it0 & 255, b = bh >> 3, h = bh & 7, t0 = b * SEQ_L + c * 64;
#pragma unroll
            for (int i = 0; i < 2; ++i) { const int id = tid + i * 512, l = id >> 4, c8 = (id & 15) * 8;
                kv[i] = *(const uint4*)(proj + (size_t)(t0 + l) * NPJ + 4096 + h * 128 + c8); vv[i] = *(const uint4*)(proj + (size_t)(t0 + l) * NPJ + 5120 + h * 128 + c8); }
            if (wave == 0) { li = gates[(size_t)(t0 + lane) * 16 + h]; lf = gates[(size_t)(t0 + lane) * 16 + 8 + h]; }
        }
    }
    for (int it = blockIdx.x; it < 4096; it += gridDim.x) {
        const int item = it;
        if (wave == 0) {
            const float bc = wscan_add(lf, lane);
            const float bL = __shfl(bc, 63);
            const float g = bL - bc + li;
            const float mg = wmaxf(g);
            wk_s[lane] = __expf(g - mg);
            if (lane == 0) { MG[item] = mg; BL[item] = bL; }
        }
        __syncthreads();
#pragma unroll
        for (int i = 0; i < 2; ++i) {
            const int id = tid + i * 512, l = id >> 4, c8 = (id & 15) * 8;
            const float w = wk_s[l];
            const int pl = ((((l >> 3) ^ (c8 >> 3)) & 7) << 3) + (l & 7);
            float kf[8], vf[8]; unpack8(kv[i], kf); unpack8(vv[i], vf);
#pragma unroll
            for (int j = 0; j < 8; j += 2) {
                const unsigned kk = pk2(kf[j], kf[j + 1]), vw = pk2(vf[j] * w, vf[j + 1] * w);
                KT[(c8 + j) * 72 + pl] = (u16)(kk & 0xffffu); KT[(c8 + j + 1) * 72 + pl] = (u16)(kk >> 16);
                VT[(c8 + j) * 72 + pl] = (u16)(vw & 0xffffu); VT[(c8 + j + 1) * 72 + pl] = (u16)(vw >> 16);
            }
        }
        {
            const int nit = it + gridDim.x;
            if (nit < 4096) {
                const int bh = nit >> 8, c = nit & 255, b = bh >> 3, h = bh & 7, t0 = b * SEQ_L + c * 64;
#pragma unroll
                for (int i = 0; i < 2; ++i) { const int id = tid + i * 512, l = id >> 4, c8 = (id & 15) * 8;
                    kv[i] = *(const uint4*)(proj + (size_t)(t0 + l) * NPJ + 4096 + h * 128 + c8); vv[i] = *(const uint4*)(proj + (size_t)(t0 + l) * NPJ + 5120 + h * 128 + c8); }
                if (wave == 0) { li = gates[(size_t)(t0 + lane) * 16 + h]; lf = gates[(size_t)(t0 + lane) * 16 + 8 + h]; }
            }
        }
        __syncthreads();
        {
            const int fr = lane & 15, fq = lane >> 4, e0 = wave * 16;
            bf16x8 bfr[2];
#pragma unroll
            for (int kk = 0; kk < 2; ++kk) bfr[kk] = *(const bf16x8*)(VT + (e0 + fr) * 72 + (((kk * 4 + fq) ^ ((e0 + fr) >> 3)) & 7) * 8);
            u16* dst = dC + (size_t)item * 16384 + (size_t)(e0 + fr) * 128 + fq * 4;
#pragma unroll
            for (int dt = 0; dt < 8; ++dt) {
                f32x4 acc = {0.f, 0.f, 0.f, 0.f};
#pragma unroll
                for (int kk = 0; kk < 2; ++kk) {
                    const bf16x8 afr = *(const bf16x8*)(KT + (dt * 16 + fr) * 72 + (((kk * 4 + fq) ^ ((dt * 16 + fr) >> 3)) & 7) * 8);
                    acc = __builtin_amdgcn_mfma_f32_16x16x32_bf16(afr, bfr[kk], acc, 0, 0, 0);
                }
                uint2 w; w.x = pk2(acc[0] * QK_SCALE, acc[1] * QK_SCALE); w.y = pk2(acc[2] * QK_SCALE, acc[3] * QK_SCALE);
                *(uint2*)(dst + dt * 16) = w;
            }
        }
        if (tid < 128) {
            float a = 0.f;
#pragma unroll
            for (int l8 = 0; l8 < 8; ++l8) {
                float kf[8]; unpack8(*(const uint4*)(KT + tid * 72 + ((l8 ^ (tid >> 3)) & 7) * 8), kf);
#pragma unroll
                for (int j = 0; j < 8; ++j) a += kf[j] * wk_s[l8 * 8 + j];
            }
            dn[(size_t)item * 128 + tid] = a * QK_SCALE;
        }
        __syncthreads();
    }
#if PROBE_DUP == 21
    __syncthreads(); }
#endif
}

__device__ void phase_scan(const Params& p) {
    const int tid = threadIdx.x;
    unsigned* dC = (unsigned*)p.out; float* dn = (float*)(p.ws + OFF_DN);
    const float* MG = (const float*)(p.ws + OFF_MG); const float* BL = (const float*)(p.ws + OFF_BL); float* MST = (float*)(p.ws + OFF_MST);
    for (int s = blockIdx.x * 512 + tid; s < 16 * 8192; s += gridDim.x * 512) {
        const int bh = s >> 13, idx = s & 8191;
        unsigned* ptr = dC + (size_t)bh * 256 * 8192 + idx;
        const bool has_n = s < 2048; const int bhn = (s >> 7) & 15;
        float* nptr = dn + (size_t)bhn * 256 * 128 + (s & 127);
        float m = 0.f, s0 = 0.f, s1 = 0.f, mn_ = 0.f, sn = 0.f;
#pragma unroll 1
        for (int c = 0; c < 256; c += 32) {
            unsigned d[32]; float dnv[32];
#pragma unroll
            for (int j = 0; j < 32; ++j) { d[j] = ptr[(size_t)(c + j) * 8192]; dnv[j] = has_n ? nptr[(size_t)(c + j) * 128] : 0.f; }
#pragma unroll
            for (int j = 0; j < 32; ++j) {
                const float mg = MG[bh * 256 + c + j], bL = BL[bh * 256 + c + j];
                const float mn = fmaxf(bL + m, mg);
                const float dec = __expf(bL + m - mn), wn = __expf(mg - mn);
                s0 = dec * s0 + wn * bflo(d[j]); s1 = dec * s1 + wn * bfhi(d[j]);
                ptr[(size_t)(c + j) * 8192] = pk2(s0, s1);
                m = mn;
                if (idx == 0) MST[bh * 256 + c + j] = mn;
                if (has_n) {
                    const float mg2 = MG[bhn * 256 + c + j], bL2 = BL[bhn * 256 + c + j];
                    const float mn2 = fmaxf(bL2 + mn_, mg2);
                    sn = __expf(bL2 + mn_ - mn2) * sn + __expf(mg2 - mn2) * dnv[j];
                    nptr[(size_t)(c + j) * 128] = sn;
                    mn_ = mn2;
                }
            }
        }
    }
}

typedef unsigned u32x4v __attribute__((ext_vector_type(4)));
typedef unsigned u32x2v __attribute__((ext_vector_type(2)));
struct MlRegs { u32x4v qv[2], kv[2], vv[2], cv[4]; u32x2v ow[4]; pg8::f32x4 gn; float li, lf, mprev, nprev; };
__device__ __forceinline__ void ml_load(const Params& p, int item, int tid, int lane, int wave, MlRegs& r) {
    const u16* proj = (const u16*)(p.ws + OFF_PROJ); const float* gates = (const float*)(p.ws + OFF_GATES);
    const u16* Cst = (const u16*)p.out; const float* nst = (const float*)(p.ws + OFF_DN); const float* MST = (const float*)(p.ws + OFF_MST);
    const int bh = item >> 8, c = item & 255, b = bh >> 3, h = bh & 7, t0 = b * SEQ_L + c * 64;
    const int fr = lane & 15, fq = lane >> 4;
#pragma unroll
    for (int i = 0; i < 2; ++i) {
        const int id = tid + i * 512, l = id >> 4, c8 = (id & 15) * 8;
        r.qv[i] = *(const u32x4v*)(proj + (size_t)(t0 + l) * NPJ + 3072 + h * 128 + c8);
        r.kv[i] = *(const u32x4v*)(proj + (size_t)(t0 + l) * NPJ + 4096 + h * 128 + c8);
        r.vv[i] = *(const u32x4v*)(proj + (size_t)(t0 + l) * NPJ + 5120 + h * 128 + c8);
    }
    {
        const int pit = (c > 0) ? item - 1 : item; const bool z = (c == 0);
        const u16* Cp = Cst + (size_t)pit * 16384;
#pragma unroll
        for (int i = 0; i < 4; ++i) { const int id = tid + i * 512, e = id >> 4, d8 = (id & 15) * 8; u32x4v v = *(const u32x4v*)(Cp + e * 128 + d8); if (z) v = (u32x4v){0u, 0u, 0u, 0u}; r.cv[i] = v; }
        float nv = nst[(size_t)pit * 128 + (tid & 127)], mv = MST[pit];
        r.nprev = z ? 0.f : nv; r.mprev = z ? 0.f : mv;
    }
#pragma unroll
    for (int lt = 0; lt < 4; ++lt) r.ow[lt] = *(const u32x2v*)(proj + (size_t)(t0 + lt * 16 + fr) * NPJ + 6144 + h * 128 + wave * 16 + fq * 4);
    r.gn = *(const pg8::f32x4*)(p.mh_g + h * 128 + wave * 16 + fq * 4);
    r.li = 0.f; r.lf = 0.f;
    if (wave == 0) { r.li = gates[(size_t)(t0 + lane) * 16 + h]; r.lf = gates[(size_t)(t0 + lane) * 16 + 8 + h]; }
}

__device__ void phase_mlstm_out(const Params& p, unsigned char* smem) {
    const int tid = threadIdx.x, lane = tid & 63, wave = tid >> 6;
    u16* ymix = (u16*)(p.ws + OFF_YMIX);
    u16* Qs = (u16*)smem;
    u16* Ks = (u16*)(smem + 17408);
    u16* VT = (u16*)(smem + 34816);
    u16* Cb = (u16*)(smem + 53248);
    u16* Ss = (u16*)(smem + 88064);
    float* fa = (float*)(smem + 97280);
    float* a_s = fa, *mm_s = fa + 64, *wi_s = fa + 128, *emt_s = fa + 192, *den_s = fa + 256, *nq_s = fa + 320, *sum_s = fa + 384, *sq_s = fa + 448, *n_s = fa + 512;
    const int fr = lane & 15, fq = lane >> 4;
    MlRegs r;
#define ML_ITEM(it_) (it_)
    if ((int)blockIdx.x < 4096) ml_load(p, ML_ITEM((int)blockIdx.x), tid, lane, wave, r);
    for (int it = blockIdx.x; it < 4096; it += gridDim.x) {
        const int item = ML_ITEM(it);
        const int bh = item >> 8, c = item & 255, b = bh >> 3, h = bh & 7;
        const int t0 = b * SEQ_L + c * 64;
        if (wave == 0) {
            const float bc = wscan_add(r.lf, lane);
            const float a = r.li - bc;
            const float pm = wscan_max(a, lane);
            const float mprev = r.mprev;
            const float mm = fmaxf(mprev, pm);
            a_s[lane] = a; mm_s[lane] = mm; wi_s[lane] = __expf(mprev - mm); emt_s[lane] = __expf(-(bc + mm));
            den_s[lane] = 0.f; sum_s[lane] = 0.f; sq_s[lane] = 0.f;
        }
#pragma unroll
        for (int i = 0; i < 2; ++i) {
            const int id = tid + i * 512, l = id >> 4, c8 = (id & 15) * 8;
            *(u32x4v*)(Qs + l * 136 + c8) = r.qv[i]; *(u32x4v*)(Ks + l * 136 + c8) = r.kv[i];
            const unsigned vw[4] = {r.vv[i].x, r.vv[i].y, r.vv[i].z, r.vv[i].w};
            const int pl = ((((l >> 3) ^ (c8 >> 3)) & 7) << 3) + (l & 7);
#pragma unroll
            for (int j = 0; j < 4; ++j) { VT[(c8 + 2 * j) * 72 + pl] = (u16)(vw[j] & 0xffffu); VT[(c8 + 2 * j + 1) * 72 + pl] = (u16)(vw[j] >> 16); }
        }
#pragma unroll
        for (int i = 0; i < 4; ++i) { const int id = tid + i * 512, e = id >> 4, d8 = (id & 15) * 8; *(u32x4v*)(Cb + e * 136 + d8) = r.cv[i]; }
        if (tid < 128) n_s[tid] = r.nprev;
        u32x2v ow[4];
#pragma unroll
        for (int lt = 0; lt < 4; ++lt) ow[lt] = r.ow[lt];
        const pg8::f32x4 gn = r.gn;
        __syncthreads();
        if (it + (int)gridDim.x < 4096) ml_load(p, ML_ITEM(it + (int)gridDim.x), tid, lane, wave, r);
        float hv[4][4];
#if PROBE_DUP == 41
        for (int prep_ = 0; prep_ < 2; ++prep_) {
        if (prep_) { __syncthreads(); if (wave == 0) { den_s[lane] = 0.f; sum_s[lane] = 0.f; sq_s[lane] = 0.f; } __syncthreads(); }
#endif
        {
            const int lt = wave >> 1, l = lt * 16 + fr; const float mml = mm_s[l];
#pragma unroll
            for (int jj = 0; jj < 2; ++jj) {
                const int jt = (wave & 1) * 2 + jj, j0 = jt * 16 + fq * 4;
                float sv[4] = {0.f, 0.f, 0.f, 0.f};
                if (jt <= lt) {
                    f32x4 acc = {0.f, 0.f, 0.f, 0.f};
#pragma unroll
                    for (int kk = 0; kk < 4; ++kk) {
                        const bf16x8 afr = *(const bf16x8*)(Ks + (jt * 16 + fr) * 136 + kk * 32 + fq * 8);
                        const bf16x8 bfr = *(const bf16x8*)(Qs + (lt * 16 + fr) * 136 + kk * 32 + fq * 8);
                        acc = __builtin_amdgcn_mfma_f32_16x16x32_bf16(afr, bfr, acc, 0, 0, 0);
                    }
#pragma unroll
                    for (int rr = 0; rr < 4; ++rr) { const int j = j0 + rr; sv[rr] = (j <= l) ? acc[rr] * QK_SCALE * __expf(a_s[j] - mml) : 0.f; }
                }
                float rs = (sv[0] + sv[1]) + (sv[2] + sv[3]);
                rs += __shfl_xor(rs, 16); rs += __shfl_xor(rs, 32);
                if (fq == 0 && jt <= lt) atomicAdd(&den_s[l], rs);
                uint2 w; w.x = pk2(sv[0], sv[1]); w.y = pk2(sv[2], sv[3]);
                *(uint2*)(Ss + l * 72 + j0) = w;
            }
        }
        {
            const int l = tid >> 3, d0 = (tid & 7) * 16; float a = 0.f;
#pragma unroll
            for (int u = 0; u < 2; ++u) {
                float qf[8]; unpack8(*(const uint4*)(Qs + l * 136 + d0 + u * 8), qf);
#pragma unroll
                for (int j = 0; j < 8; ++j) a += qf[j] * n_s[d0 + u * 8 + j];
            }
            a += __shfl_xor(a, 1); a += __shfl_xor(a, 2); a += __shfl_xor(a, 4);
            if ((tid & 7) == 0) nq_s[l] = a;
        }
        __syncthreads();
        {
            const int e0 = wave * 16;
            bf16x8 av[2], ac[4];
#pragma unroll
            for (int kk = 0; kk < 2; ++kk) av[kk] = *(const bf16x8*)(VT + (e0 + fr) * 72 + (((kk * 4 + fq) ^ ((e0 + fr) >> 3)) & 7) * 8);
#pragma unroll
            for (int kk = 0; kk < 4; ++kk) ac[kk] = *(const bf16x8*)(Cb + (e0 + fr) * 136 + kk * 32 + fq * 8);
#pragma unroll
            for (int lt = 0; lt < 4; ++lt) {
                const int l = lt * 16 + fr;
                f32x4 a1 = {0.f, 0.f, 0.f, 0.f}, a2 = {0.f, 0.f, 0.f, 0.f};
#pragma unroll
                for (int kk = 0; kk < 2; ++kk) { const bf16x8 bs = *(const bf16x8*)(Ss + l * 72 + kk * 32 + fq * 8); a1 = __builtin_amdgcn_mfma_f32_16x16x32_bf16(av[kk], bs, a1, 0, 0, 0); }
#pragma unroll
                for (int kk = 0; kk < 4; ++kk) { const bf16x8 bq = *(const bf16x8*)(Qs + l * 136 + kk * 32 + fq * 8); a2 = __builtin_amdgcn_mfma_f32_16x16x32_bf16(ac[kk], bq, a2, 0, 0, 0); }
                const float wi = wi_s[l];
                const float den = den_s[l] + wi * nq_s[l];
                const float inv = 1.0f / fmaxf(fabsf(den), emt_s[l]);
                float s1 = 0.f, s2 = 0.f;
#pragma unroll
                for (int rr = 0; rr < 4; ++rr) { const float hh = (a1[rr] + wi * a2[rr]) * inv; hv[lt][rr] = hh; s1 += hh; s2 += hh * hh; }
                s1 += __shfl_xor(s1, 16); s1 += __shfl_xor(s1, 32); s2 += __shfl_xor(s2, 16); s2 += __shfl_xor(s2, 32);
                if (fq == 0) { atomicAdd(&sum_s[l], s1); atomicAdd(&sq_s[l], s2); }
            }
        }
#if PROBE_DUP == 41
        }
#endif
        __syncthreads();
        {
            const int e = wave * 16 + fq * 4;
#pragma unroll
            for (int lt = 0; lt < 4; ++lt) {
                const int l = lt * 16 + fr;
                const float mean = sum_s[l] * (1.0f / 128.0f);
                const float var = fmaxf(sq_s[l] * (1.0f / 128.0f) - mean * mean, 0.f);
                const float rstd = rsqrtf(var + LN_EPS_F);
                const float o0 = bflo(ow[lt].x), o1 = bfhi(ow[lt].x), o2 = bflo(ow[lt].y), o3 = bfhi(ow[lt].y);
                const float y0 = (hv[lt][0] - mean) * rstd * gn[0] / (1.0f + __expf(-o0));
                const float y1 = (hv[lt][1] - mean) * rstd * gn[1] / (1.0f + __expf(-o1));
                const float y2 = (hv[lt][2] - mean) * rstd * gn[2] / (1.0f + __expf(-o2));
                const float y3 = (hv[lt][3] - mean) * rstd * gn[3] / (1.0f + __expf(-o3));
                uint2 w; w.x = pk2(y0, y1); w.y = pk2(y2, y3);
                *(uint2*)(ymix + (size_t)(t0 + l) * DM + 1024 + h * 128 + e) = w;
            }
        }
        __syncthreads();
    }
}

struct EpiPre {
    static constexpr bool PERM = false, AFTER_DRAIN = false;
    float* C; const u16* h0;
    __device__ __forceinline__ void operator()(const f32x4 (&acc)[2][2][4][2], const pg8::Unit& u, int wr, int wc, int fr, int fq) const {
        const int row0 = u.pm * 256 + wr * 64 + fr, col0 = u.pn * 256 + wc * 32 + 4 * fq;
#pragma unroll
        for (int ai = 0; ai < 2; ++ai)
#pragma unroll
            for (int m = 0; m < 4; ++m) {
                const size_t ro = (size_t)(row0 + ai * 128 + m * 16) * DM + col0;
#pragma unroll
                for (int bj = 0; bj < 2; ++bj)
#pragma unroll
                    for (int n = 0; n < 2; ++n) {
                        const uint2 hb = *(const uint2*)(h0 + ro + bj * 128 + n * 16);
                        f32x4 r = acc[ai][bj][m][n];
                        r[0] += ALPHA_F * bflo(hb.x); r[1] += ALPHA_F * bfhi(hb.x); r[2] += ALPHA_F * bflo(hb.y); r[3] += ALPHA_F * bfhi(hb.y);
                        *(f32x4*)(C + ro + bj * 128 + n * 16) = r;
                    }
            }
    }
};

__device__ void phase_ln1(const Params& p) {
    const int tid = threadIdx.x, lane = tid & 63, wave = tid >> 6;
    u16* h1b = (u16*)(p.ws + OFF_H1B); float* lns = (float*)(p.ws + OFF_LNS); unsigned char* h1f8 = p.ws + OFF_H1F8; float* xsc = (float*)(p.ws + OFF_XSC);
    const u16* h0b = (const u16*)(p.ws + OFF_H0B); const u16* mixb = (const u16*)(p.ws + OFF_MIXB);
    float4 lg[8], lb[8];
#pragma unroll
    for (int i = 0; i < 8; ++i) { lg[i] = *(const float4*)(p.ln1_g + i * 256 + lane * 4); lb[i] = *(const float4*)(p.ln1_b + i * 256 + lane * 4); }
    uint2 hn[8], mn[8];
    {
        const int tok = blockIdx.x * 8 + wave;
        if (tok < T_TOK) {
#pragma unroll
            for (int i = 0; i < 8; ++i) { hn[i] = *(const uint2*)(h0b + (size_t)tok * DM + i * 256 + lane * 4); mn[i] = *(const uint2*)(mixb + (size_t)tok * DM + i * 256 + lane * 4); } }
    }
    for (int tok = blockIdx.x * 8 + wave; tok < T_TOK; tok += gridDim.x * 8) {
        float4 xv[8];
#pragma unroll
        for (int i = 0; i < 8; ++i) {
            const uint2 hw = hn[i], mw = mn[i];
            xv[i].x = ALPHA_F * bflo(hw.x) + bflo(mw.x); xv[i].y = ALPHA_F * bfhi(hw.x) + bfhi(mw.x); xv[i].z = ALPHA_F * bflo(hw.y) + bflo(mw.y); xv[i].w = ALPHA_F * bfhi(hw.y) + bfhi(mw.y);
        }
        {
            const int ntok = tok + gridDim.x * 8;
            if (ntok < T_TOK) {
#pragma unroll
                for (int i = 0; i < 8; ++i) { hn[i] = *(const uint2*)(h0b + (size_t)ntok * DM + i * 256 + lane * 4); mn[i] = *(const uint2*)(mixb + (size_t)ntok * DM + i * 256 + lane * 4); } }
        }
        float s = 0.f;
#pragma unroll
        for (int i = 0; i < 8; ++i) s += (xv[i].x + xv[i].y) + (xv[i].z + xv[i].w);
        const float mean = wsum(s) * (1.0f / 2048.0f);
        float q = 0.f;
#pragma unroll
        for (int i = 0; i < 8; ++i) { xv[i].x -= mean; xv[i].y -= mean; xv[i].z -= mean; xv[i].w -= mean; q += xv[i].x * xv[i].x + xv[i].y * xv[i].y + xv[i].z * xv[i].z + xv[i].w * xv[i].w; }
        const float rstd = rsqrtf(wsum(q) * (1.0f / 2048.0f) + LN_EPS_F);
        float amx = 0.f;
#pragma unroll
        for (int i = 0; i < 8; ++i) {
            const float4 g4 = lg[i], b4 = lb[i];
            float4 y; y.x = xv[i].x * rstd * g4.x + b4.x; y.y = xv[i].y * rstd * g4.y + b4.y; y.z = xv[i].z * rstd * g4.z + b4.z; y.w = xv[i].w * rstd * g4.w + b4.w;
            uint2 w; w.x = pk2(y.x, y.y); w.y = pk2(y.z, y.w);
            *(uint2*)(h1b + (size_t)tok * DM + i * 256 + lane * 4) = w;
            xv[i] = y; amx = fmaxf(amx, fmaxf(fmaxf(fabsf(y.x), fabsf(y.y)), fmaxf(fabsf(y.z), fabsf(y.w))));
        }
        amx = wmaxf(amx);
        {
            const float qs = amx > 0.f ? 127.0f / amx : 0.f;
#pragma unroll
            for (int i = 0; i < 8; ++i) {
                const int q0 = (int)rintf(xv[i].x * qs), q1 = (int)rintf(xv[i].y * qs), q2 = (int)rintf(xv[i].z * qs), q3 = (int)rintf(xv[i].w * qs);
                *(unsigned*)(h1f8 + (size_t)tok * DM + i * 256 + lane * 4) = (unsigned)(q0 & 255) | ((unsigned)(q1 & 255) << 8) | ((unsigned)(q2 & 255) << 16) | ((unsigned)(q3 & 255) << 24);
            }
            if (lane == 0) xsc[tok] = amx * (1.0f / 127.0f);
        }
        if (lane == 0) *(float2*)(lns + (size_t)tok * 2) = make_float2(mean, rstd);
    }
}

__device__ __forceinline__ int f2key(float f) { const int b = __float_as_int(f); return b ^ ((b >> 31) & 0x7fffffff); }
__device__ __forceinline__ float key2f(int k) { return __int_as_float(k ^ ((k >> 31) & 0x7fffffff)); }
__device__ __forceinline__ void ce_desc(int& a, int& b) { const int hi = max(a, b), lo = min(a, b); a = hi; b = lo; }
template <int OFF> __device__ __forceinline__ void sort16_desc(int (&v)[64]) {
#pragma unroll
    for (int k = 2; k <= 16; k <<= 1)
#pragma unroll
        for (int j = k >> 1; j > 0; j >>= 1)
#pragma unroll
            for (int i = 0; i < 16; ++i) { const int l = i ^ j; if (l > i) { if ((i & k) == 0) ce_desc(v[OFF + i], v[OFF + l]); else ce_desc(v[OFF + l], v[OFF + i]); } }
}
template <int OA, int OB> __device__ __forceinline__ void merge16_desc(int (&v)[64]) {
#pragma unroll
    for (int i = 0; i < 16; ++i) v[OA + i] = max(v[OA + i], v[OB + 15 - i]);
#pragma unroll
    for (int j = 8; j > 0; j >>= 1)
#pragma unroll
        for (int i = 0; i < 16; ++i) { const int l = i ^ j; if (l > i) ce_desc(v[OA + i], v[OA + l]); }
}
__device__ __forceinline__ void top16_of_64(int (&v)[64]) {
    sort16_desc<0>(v); sort16_desc<16>(v); sort16_desc<32>(v); sort16_desc<48>(v);
    merge16_desc<0, 16>(v); merge16_desc<32, 48>(v); merge16_desc<0, 32>(v);
}

__device__ void phase_select(const Params& p, unsigned char* smem) {
    const int tid = threadIdx.x, lane = tid & 63, wave = tid >> 6;
    const u16* qb = (const u16*)(p.ws + OFF_QB); const u16* keyb = (const u16*)(p.ws + OFF_KEYB);
    int* eidp = (int*)(p.ws + OFF_EID); float* gwp = (float*)(p.ws + OFF_GW);
    u16* key_s = (u16*)smem;
    unsigned char* lut = smem + 69632 + wave * 2048 + lane * 32;
    const int col = lane & 31, hi = lane >> 5;
    const int h = blockIdx.x & 7;
    const int nb = (gridDim.x + 7 - h) >> 3;
    for (int i = tid; i < 4096; i += 512) { const int r = i >> 4, c8 = (i & 15) * 8; *(uint4*)(key_s + r * 136 + c8) = *(const uint4*)(keyb + (size_t)(h * 256 + r) * 128 + c8); }
    __syncthreads();
    for (int tile = (blockIdx.x >> 3) + nb * wave; tile < 1024; tile += nb * 8) {
        const int t0 = tile * 32;
        int sv[2][16];
#pragma unroll
        for (int pp = 0; pp < 2; ++pp) {
            bf16x8 bq[8];
#pragma unroll
            for (int kk = 0; kk < 8; ++kk) bq[kk] = *(const bf16x8*)(qb + (size_t)(t0 + col) * DM + h * 256 + pp * 128 + kk * 16 + hi * 8);
            f32x16 acc[4];
#pragma unroll
            for (int mt = 0; mt < 4; ++mt)
#pragma unroll
                for (int r = 0; r < 16; ++r) acc[mt][r] = 0.f;
            const u16* kb = key_s + pp * 128 * 136;
#pragma unroll
            for (int kk = 0; kk < 8; ++kk) {
#pragma unroll
                for (int mt = 0; mt < 4; ++mt) {
                    const bf16x8 ak = *(const bf16x8*)(kb + (mt * 32 + col) * 136 + kk * 16 + hi * 8);
                    acc[mt] = __builtin_amdgcn_mfma_f32_32x32x16_bf16(ak, bq[kk], acc[mt], 0, 0, 0);
                }
            }
            int v[64];
#pragma unroll
            for (int mt = 0; mt < 4; ++mt)
#pragma unroll
                for (int r = 0; r < 16; ++r) { const int n = 32 * mt + 8 * (r >> 2) + (r & 3) + 4 * hi; v[mt * 16 + r] = (f2key(acc[mt][r]) & ~127) | n; }
            top16_of_64(v);
#pragma unroll
            for (int i = 0; i < 16; ++i) v[16 + i] = __shfl_xor(v[i], 32);
            merge16_desc<0, 16>(v);
#pragma unroll
            for (int i = 0; i < 16; ++i) sv[pp][i] = v[i];
        }
        float f0[16], f1[16];
#pragma unroll
        for (int i = 0; i < 16; ++i) { f0[i] = key2f(sv[0][i] & ~127); f1[i] = key2f(sv[1][i] & ~127); lut[i] = (unsigned char)(sv[0][i] & 127); lut[16 + i] = (unsigned char)(sv[1][i] & 127); }
        int v[64]; int cnt = 0;
#pragma unroll
        for (int a = 0; a < 16; ++a)
#pragma unroll
            for (int b = 0; b < 16; ++b)
                if ((a + 1) * (b + 1) <= 16) { v[cnt] = (f2key(f0[a] + f1[b]) & ~255) | (a * 16 + b); ++cnt; }
#pragma unroll
        for (int i = 50; i < 64; ++i) v[i] = f2key(-1e30f);
        top16_of_64(v);
        float ev[16]; float ssum = 0.f; const float mx = key2f(v[0] & ~255);
#pragma unroll
        for (int k = 0; k < 16; ++k) { ev[k] = __expf(key2f(v[k] & ~255) - mx); ssum += ev[k]; }
        const float inv = 1.0f / ssum;
        const size_t ob = ((size_t)(t0 + col) * 8 + h) * 16;
#pragma unroll
        for (int k = 0; k < 16; ++k) {
            const int code = v[k] & 255;
            const int i0 = lut[code >> 4], i1 = lut[16 + (code & 15)];
            if ((k >> 3) == hi) { eidp[ob + k] = i0 * 128 + i1; gwp[ob + k] = ev[k] * inv; }
        }
    }
}

struct ExpCtx { const u16* h1b; const unsigned char* tab; const int* eid_s; float* part_s; float* out; const float* lns; const float* g1; const float* b1; const u16* h0b; const u16* mixb; const unsigned char* h1f8; int tbase, lane, j, g; };
__device__ __forceinline__ void exp_load(const ExpCtx& c, int step, uint4 (&seg)[16]) {
    const int cb = step >> 4, tt = step & 15;
    const unsigned char* ts = c.tab + (size_t)cb * SLICE_BYTES;
    const unsigned go = (unsigned)c.g * 16u;
    int e[16];
#pragma unroll
    for (int m = 0; m < 4; ++m) { const int4 v = *(const int4*)(c.eid_s + tt * 128 + c.j * 16 + m * 4); e[m * 4] = v.x; e[m * 4 + 1] = v.y; e[m * 4 + 2] = v.z; e[m * 4 + 3] = v.w; }
#pragma unroll
    for (int i = 0; i < 16; ++i) seg[i] = *(const uint4*)(ts + ((unsigned)e[i] * 128u + go));
}
__device__ __forceinline__ void u_loadx(const ExpCtx& c, int step, uint4 (&xw)[2]) {
    const int cb = step >> 4, tt = step & 15;
    xw[0] = *(const uint4*)(c.h1f8 + (size_t)(c.tbase + tt) * DM + cb * 128 + c.g * 16);
}
__device__ __forceinline__ void u_compute(const ExpCtx& c, int step, const uint4 (&seg)[16], const uint4 (&xw)[2]) {
    const int cb = step >> 4, tt = step & 15, lane = c.lane;
    const int x0 = (int)xw[0].x, x1 = (int)xw[0].y, x2 = (int)xw[0].z, x3 = (int)xw[0].w;
    int part[16];
#pragma unroll
    for (int i = 0; i < 16; ++i) {
        int a = __builtin_amdgcn_sdot4((int)seg[i].x, x0, 0, false);
        a = __builtin_amdgcn_sdot4((int)seg[i].y, x1, a, false);
        a = __builtin_amdgcn_sdot4((int)seg[i].z, x2, a, false);
        part[i] = __builtin_amdgcn_sdot4((int)seg[i].w, x3, a, false);
    }
    const bool up2 = (lane & 4) != 0, up1 = (lane & 2) != 0, up0 = (lane & 1) != 0;
#pragma unroll
    for (int i = 0; i < 8; ++i) { const int a = part[i], b = part[i + 8]; part[i] = (up2 ? b : a) + __shfl_xor(up2 ? a : b, 4); }
#pragma unroll
    for (int i = 0; i < 4; ++i) { const int a = part[i], b = part[i + 4]; part[i] = (up1 ? b : a) + __shfl_xor(up1 ? a : b, 2); }
#pragma unroll
    for (int i = 0; i < 2; ++i) { const int a = part[i], b = part[i + 2]; part[i] = (up0 ? b : a) + __shfl_xor(up0 ? a : b, 1); }
    int2* ps = (int2*)(c.part_s + tt * 128 + 2 * lane);
    int2 o = make_int2(part[0], part[1]);
    if (cb != 0) { const int2 old = *ps; o.x += old.x; o.y += old.y; }
    *ps = o;
}
struct VRes { unsigned hw, mw; float2 st; };
__device__ __forceinline__ void v_loadres(const ExpCtx& c, int step, VRes& r) {
    const int cb = step >> 4, tt = step & 15; const int co = cb * 128 + c.g * 16 + 2 * c.j;
    r.hw = *(const unsigned*)(c.h0b + (size_t)(c.tbase + tt) * DM + co); r.mw = *(const unsigned*)(c.mixb + (size_t)(c.tbase + tt) * DM + co);
    r.st = *(const float2*)(c.lns + (size_t)(c.tbase + tt) * 2);
}
__device__ __forceinline__ void v_compute(const ExpCtx& c, int step, const uint4 (&seg)[16], const VRes& vr, float2& g1, float2& b1) {
    const int cb = step >> 4, tt = step & 15, lane = c.lane;
    f32x2 acc[8];
#pragma unroll
    for (int k = 0; k < 8; ++k) acc[k] = (f32x2){0.f, 0.f};
#pragma unroll
    for (int m = 0; m < 4; ++m) {
        const float4 f = *(const float4*)(c.part_s + tt * 128 + c.j * 16 + m * 4);
        const float wv[4] = {f.x, f.y, f.z, f.w};
#pragma unroll
        for (int ii = 0; ii < 4; ++ii) {
            const int i = m * 4 + ii;
            const unsigned w[4] = {seg[i].x, seg[i].y, seg[i].z, seg[i].w};
            const f32x2 w2 = (f32x2){wv[ii], wv[ii]};
#pragma unroll
            for (int d = 0; d < 4; ++d) { acc[2 * d] += w2 * __builtin_amdgcn_cvt_pk_f32_fp8((int)w[d], false); acc[2 * d + 1] += w2 * __builtin_amdgcn_cvt_pk_f32_fp8((int)w[d], true); }
        }
    }
    float v[16];
#pragma unroll
    for (int k = 0; k < 8; ++k) { v[2 * k] = acc[k].x; v[2 * k + 1] = acc[k].y; }
    const bool up5 = (lane & 32) != 0, up4 = (lane & 16) != 0, up3 = (lane & 8) != 0;
#pragma unroll
    for (int i = 0; i < 8; ++i) { const float a = v[i], b = v[i + 8]; v[i] = (up5 ? b : a) + __shfl_xor(up5 ? a : b, 32); }
#pragma unroll
    for (int i = 0; i < 4; ++i) { const float a = v[i], b = v[i + 4]; v[i] = (up4 ? b : a) + __shfl_xor(up4 ? a : b, 16); }
#pragma unroll
    for (int i = 0; i < 2; ++i) { const float a = v[i], b = v[i + 2]; v[i] = (up3 ? b : a) + __shfl_xor(up3 ? a : b, 8); }
    const int co = cb * 128 + c.g * 16 + 2 * c.j;
    float2* op = (float2*)(c.out + (size_t)(c.tbase + tt) * DM + co);
    const float2 hh = make_float2(ALPHA_F * bflo(vr.hw) + bflo(vr.mw), ALPHA_F * bfhi(vr.hw) + bfhi(vr.mw));
    const float2 st = vr.st;
    if (tt == 0) { g1 = *(const float2*)(c.g1 + co); b1 = *(const float2*)(c.b1 + co); }
    *op = make_float2(ALPHA_F * ((hh.x - st.x) * st.y * g1.x + b1.x) + v[0], ALPHA_F * ((hh.y - st.x) * st.y * g1.y + b1.y) + v[1]);
}

__device__ void phase_experts(const Params& p, unsigned char* smem) {
    const int tid = threadIdx.x, lane = tid & 63, wave = tid >> 6;
    const float* usc = (const float*)(p.ws + OFF_USC); const float* vsc = (const float*)(p.ws + OFF_VSC);
    const int* eidp = (const int*)(p.ws + OFF_EID); const float* gwp = (const float*)(p.ws + OFF_GW); const float* xsc = (const float*)(p.ws + OFF_XSC);
    int* eid_s = (int*)smem + wave * 2048;
    float* part_s = (float*)(smem + 65536) + wave * 2048;
    ExpCtx c; c.h1b = (const u16*)(p.ws + OFF_H1B); c.eid_s = eid_s; c.part_s = part_s; c.out = p.out; c.lns = (const float*)(p.ws + OFF_LNS); c.g1 = p.ln1_g; c.b1 = p.ln1_b; c.h0b = (const u16*)(p.ws + OFF_H0B); c.mixb = (const u16*)(p.ws + OFF_MIXB); c.h1f8 = p.ws + OFF_H1F8; c.lane = lane; c.j = lane >> 3; c.g = lane & 7;
    for (int tg = blockIdx.x; tg < 256; tg += gridDim.x) {
        const int tbase = tg * 128 + wave * 16; c.tbase = tbase;
#pragma unroll
        for (int k = 0; k < 8; ++k) *(uint4*)(eid_s + k * 256 + lane * 4) = *(const uint4*)(eidp + (size_t)tbase * 128 + k * 256 + lane * 4);
#if defined(PROBE_DUP) && PROBE_DUP == 90
#pragma unroll 1
        for (int urep = 0; urep < 2; ++urep)
#endif
        {
            c.tab = p.ws + OFF_UBF;
            uint4 segA[16], segB[16], xA[2], xB[2];
            exp_load(c, 0, segA); u_loadx(c, 0, xA);
#pragma unroll 1
            for (int step = 0; step < 256; step += 2) {
                exp_load(c, step + 1, segB); u_loadx(c, step + 1, xB);
                u_compute(c, step, segA, xA);
                if (step + 2 < 256) { exp_load(c, step + 2, segA); u_loadx(c, step + 2, xA); }
                u_compute(c, step + 1, segB, xB);
            }
        }
#pragma unroll 1
        for (int tt = 0; tt < 16; ++tt) {
            const int t = tbase + tt;
            const int2 ee = *(const int2*)(eid_s + tt * 128 + 2 * lane);
            const float2 gw = *(const float2*)(gwp + (size_t)t * 128 + 2 * lane);
            float2* ps = (float2*)(part_s + tt * 128 + 2 * lane);
            const int2 pi2 = *(const int2*)ps; const float xs = xsc[t];
            const float a0 = (float)pi2.x * (usc[ee.x] * xs), a1 = (float)pi2.y * (usc[ee.y] * xs);
            float2 o;
            o.x = gw.x * vsc[ee.x] * 0.5f * a0 * (1.0f + erff(a0 * 0.70710678118654752f));
            o.y = gw.y * vsc[ee.y] * 0.5f * a1 * (1.0f + erff(a1 * 0.70710678118654752f));
            *ps = o;
        }
        {
            c.tab = p.ws + OFF_VBF;
            uint4 segA[16], segB[16]; VRes rA, rB; float2 g1 = make_float2(0.f, 0.f), b1 = make_float2(0.f, 0.f);
            exp_load(c, 0, segA); v_loadres(c, 0, rA);
#pragma unroll 1
            for (int step = 0; step < 256; step += 2) {
                exp_load(c, step + 1, segB); v_loadres(c, step + 1, rB);
                v_compute(c, step, segA, rA, g1, b1);
                if (step + 2 < 256) { exp_load(c, step + 2, segA); v_loadres(c, step + 2, rA); }
                v_compute(c, step + 1, segB, rB, g1, b1);
            }
        }
        float4 l2g[8], l2b[8];
#pragma unroll
        for (int i = 0; i < 8; ++i) { l2g[i] = *(const float4*)(p.ln2_g + i * 256 + lane * 4); l2b[i] = *(const float4*)(p.ln2_b + i * 256 + lane * 4); }
        float4 xnx[8];
#pragma unroll
        for (int i = 0; i < 8; ++i) xnx[i] = *(const float4*)(p.out + (size_t)tbase * DM + i * 256 + lane * 4);
#pragma unroll 1
        for (int tt = 0; tt < 16; ++tt) {
            float4 xv[8]; float* xr = p.out + (size_t)(tbase + tt) * DM;
#pragma unroll
            for (int i = 0; i < 8; ++i) xv[i] = xnx[i];
            if (tt + 1 < 16) {
#pragma unroll
                for (int i = 0; i < 8; ++i) xnx[i] = *(const float4*)(xr + DM + i * 256 + lane * 4); }
            float s = 0.f;
#pragma unroll
            for (int i = 0; i < 8; ++i) s += (xv[i].x + xv[i].y) + (xv[i].z + xv[i].w);
            const float mean = wsum(s) * (1.0f / 2048.0f);
            float q = 0.f;
#pragma unroll
            for (int i = 0; i < 8; ++i) { xv[i].x -= mean; xv[i].y -= mean; xv[i].z -= mean; xv[i].w -= mean; q += xv[i].x * xv[i].x + xv[i].y * xv[i].y + xv[i].z * xv[i].z + xv[i].w * xv[i].w; }
            const float rstd = rsqrtf(wsum(q) * (1.0f / 2048.0f) + LN_EPS_F);
#pragma unroll
            for (int i = 0; i < 8; ++i) {
                const float4 g4 = l2g[i], b4 = l2b[i];
                float4 y; y.x = xv[i].x * rstd * g4.x + b4.x; y.y = xv[i].y * rstd * g4.y + b4.y; y.z = xv[i].z * rstd * g4.z + b4.z; y.w = xv[i].w * rstd * g4.w + b4.w;
                *(float4*)(xr + i * 256 + lane * 4) = y;
            }
        }
    }
}

__global__ __launch_bounds__(512, 2) void mega(Params p, int lo, int hi) {
    extern __shared__ __attribute__((aligned(16))) unsigned char smem[];
    cg::grid_group grid = cg::this_grid();
#ifndef PROBE_DUP
#define PROBE_DUP -1
#endif
    __shared__ uint4 xb_words;
    unsigned* bar = (unsigned*)(p.ws + OFF_BAR);
    if (blockIdx.x == 0) for (int i = threadIdx.x; i < XCD_BAR_WORDS; i += 512) bar[i] = 0u;
    if (threadIdx.x == 0) xb_words = make_uint4(0u, 0u, 0u, 0u);
    __syncthreads();
    XcdBarrier xb; xb.bar = bar; xb.x = 0u; xb.st = (volatile LAS unsigned*)&xb_words;
#define SEAM(i) do { if ((i) == 0) { grid.sync(); xb = xcd_barrier_post(bar, (volatile LAS unsigned*)&xb_words); } else xcd_barrier(xb); } while (0)
#define PH_BEGIN(i) if ((i) >= lo && (i) < hi) for (int rep_ = 0; rep_ < (((i) == PROBE_DUP) ? 2 : 1); ++rep_) { if (rep_) { if ((i) == 0) grid.sync(); else xcd_barrier(xb); }
#define PH_END(i) } if ((i) + 1 > lo && (i) + 1 < hi) SEAM(i);
    PH_BEGIN(0) phase_prep(p, smem); PH_END(0)
    PH_BEGIN(1) {
        pg8::Gemm g{(const pg8::bf16_t*)(p.ws + OFF_H0B), (const pg8::bf16_t*)(p.ws + OFF_WINT), T_TOK, NPJ, DM};
        pg8::StaticOrder S; S.init(g.M, g.N, (int)gridDim.x, (int)blockIdx.x);
        pg8::EpiBf16<0> E{(pg8::bf16_t*)(p.ws + OFF_PROJ), NPJ, nullptr, 0, 0, 1};
        pg8::gemm_phase<pg8::EpiBf16<0>, pg8::StaticOrder, false>((PG8_LAS unsigned char*)smem, g, S, E, nullptr);
    } PH_END(1)
    PH_BEGIN(2) phase_conv_local(p, smem); PH_END(2)
    PH_BEGIN(3) phase_scan(p); PH_END(3)
    PH_BEGIN(4) phase_mlstm_out(p, smem); PH_END(4)
    PH_BEGIN(5) {
        pg8::Gemm g{(const pg8::bf16_t*)(p.ws + OFF_YMIX), (const pg8::bf16_t*)(p.ws + OFF_WOUTT), T_TOK, DM, DM};
        pg8::StaticOrder S; S.init(g.M, g.N, (int)gridDim.x, (int)blockIdx.x);
        pg8::EpiBf16<0> E{(pg8::bf16_t*)(p.ws + OFF_MIXB), DM, nullptr, 0, 0};
        pg8::gemm_phase<pg8::EpiBf16<0>, pg8::StaticOrder, false>((PG8_LAS unsigned char*)smem, g, S, E, nullptr);
    } PH_END(5)
    PH_BEGIN(6) phase_ln1(p); PH_END(6)
    PH_BEGIN(7) {
        pg8::Gemm g{(const pg8::bf16_t*)(p.ws + OFF_H1B), (const pg8::bf16_t*)(p.ws + OFF_WQT), T_TOK, DM, DM};
        pg8::StaticOrder S; S.init(g.M, g.N, (int)gridDim.x, (int)blockIdx.x);
        pg8::EpiBf16<0> E{(pg8::bf16_t*)(p.ws + OFF_QB), DM, nullptr, 0, 0};
        pg8::gemm_phase<pg8::EpiBf16<0>, pg8::StaticOrder, false>((PG8_LAS unsigned char*)smem, g, S, E, nullptr);
    } PH_END(7)
    PH_BEGIN(8) phase_select(p, smem); PH_END(8)
    PH_BEGIN(9) phase_experts(p, smem); PH_END(9)
#if PROBE_DUP == 100
    for (int r_ = 0; r_ < 20; ++r_) xcd_barrier(xb);
#endif
}

#define LDS_BYTES 131072
extern "C" void kernel_launch(void* const* d_in, const int* in_sizes, int n_in, void* d_out, int out_size, void* d_ws, size_t ws_size, hipStream_t stream) {
    static int grid_blocks = 0;
    if (!grid_blocks) {
        hipFuncSetAttribute((const void*)mega, hipFuncAttributeMaxDynamicSharedMemorySize, LDS_BYTES);
        int dev = 0, cus = 0, per_cu = 0;
        hipGetDevice(&dev);
        hipDeviceGetAttribute(&cus, hipDeviceAttributeMultiprocessorCount, dev);
        hipOccupancyMaxActiveBlocksPerMultiprocessor(&per_cu, mega, 512, LDS_BYTES);
        if (per_cu < 1) per_cu = 1;
        grid_blocks = cus * per_cu;
        if (grid_blocks > 256) grid_blocks = 256;
    }
    if (ws_size < (size_t)1011 * 1024 * 1024) { fprintf(stderr, "workspace too small: %zu\n", ws_size); return; }
    Params p{};
    p.x = (const float*)d_in[0]; p.ln_in_g = (const float*)d_in[1]; p.ln_in_b = (const float*)d_in[2]; p.w_in = (const float*)d_in[3]; p.b_gate = (const float*)d_in[4];
    p.conv_w = (const float*)d_in[5]; p.conv_b = (const float*)d_in[6]; p.mh_g = (const float*)d_in[7]; p.w_out = (const float*)d_in[8]; p.ln1_g = (const float*)d_in[9]; p.ln1_b = (const float*)d_in[10];
    p.wq = (const float*)d_in[11]; p.keys = (const float*)d_in[12]; p.pu = (const float*)d_in[13]; p.pv = (const float*)d_in[14]; p.ln2_g = (const float*)d_in[15]; p.ln2_b = (const float*)d_in[16];
    p.out = (float*)d_out; p.ws = (unsigned char*)d_ws;
#ifdef MULTI_LAUNCH
    for (int i = 0; i < 10; ++i) { hipLaunchKernelGGL(mega, dim3(grid_blocks), dim3(512), LDS_BYTES, stream, p, i, i + 1); }
#else
    int lo = 0, hi = 10;
    void* args[] = {&p, &lo, &hi};
    hipError_t e = hipLaunchCooperativeKernel((void*)mega, dim3(grid_blocks), dim3(512), args, LDS_BYTES, stream);
    if (e != hipSuccess) fprintf(stderr, "cooperative launch failed: %s (grid %d)\n", hipGetErrorString(e), grid_blocks);
#endif
}
```
